# Optimizing an MI355X kernel written in HIP

```python
import jax, jax.numpy as jnp
from jax import lax
import numpy as np

D_MODEL = 1024
BATCH = 2
SEQ = 16384
DEPTH = 4

N_META = 16
N_MIXERS = 4
D_MIX = D_MODEL
GROUP_W = D_MIX // N_MIXERS
HEAD = 64
N_H = GROUP_W // HEAD
POOL_WINDOWS = (2, 4, 8, 16)
RW_W_RANK = 32
RW_A_RANK = 32
RW_V_RANK = 32
RW_G_RANK = 64
RW_COLS = 3 * GROUP_W + RW_W_RANK + RW_A_RANK + RW_G_RANK
RW_SPLITS = (GROUP_W, 2 * GROUP_W, 3 * GROUP_W, 3 * GROUP_W + RW_W_RANK, 3 * GROUP_W + RW_W_RANK + RW_A_RANK)
LRU_C = 8.0
CONV_W = 4
ML_CHUNK = 64
ML_COLS = 4 * GROUP_W + 2 * N_H
PROJ_SPLITS = (GROUP_W, GROUP_W + RW_COLS, 2 * GROUP_W + RW_COLS, 3 * GROUP_W + RW_COLS)
D_IN = 3 * GROUP_W + RW_COLS + ML_COLS
D_FF = 4 * D_MODEL
ALPHA = (2 * DEPTH) ** 0.25
BETA = (8 * DEPTH) ** -0.25
LN_EPS = 1e-5
GN_EPS = 64e-5
NEG = -1e30

kernel_name = 'hybrid_parallel_heads_pool_rwkv7_rglru_mlstm'


def layer_norm(x, g, b):
    xf = x.astype(jnp.float32)
    mu = jnp.mean(xf, -1, keepdims=True)
    var = jnp.mean(jnp.square(xf - mu), -1, keepdims=True)
    return ((xf - mu) * lax.rsqrt(var + LN_EPS) * g + b).astype(x.dtype)


def head_norm(y, g, b):
    mu = jnp.mean(y, -1, keepdims=True)
    var = jnp.mean(jnp.square(y - mu), -1, keepdims=True)
    yn = (y - mu) * lax.rsqrt(var + GN_EPS)
    return yn.reshape(y.shape[0], y.shape[1], -1) * g + b


def split_heads(z):
    return z.reshape(z.shape[0], z.shape[1], N_H, HEAD).astype(jnp.float32)


def token_shift(z):
    return jnp.pad(z, ((0, 0), (1, 0), (0, 0)))[:, :-1]


def causal_dwconv(z, w, b):
    y = lax.conv_general_dilated(z, w[:, None, :].astype(z.dtype), window_strides=(1,),
                                 padding=[(CONV_W - 1, 0)], dimension_numbers=('NWC', 'WIO', 'NWC'),
                                 feature_group_count=z.shape[-1])
    return y + b


def pool_mixer(u, w_blk, scale):
    B, T, _ = u.shape
    uf = u.astype(jnp.float32)
    cs = jnp.pad(jnp.cumsum(uf, axis=1), ((0, 0), (1, 0), (0, 0)))
    pos = jnp.arange(T, dtype=jnp.float32)
    groups = []
    for gi, w in enumerate(POOL_WINDOWS):
        c = cs[:, :, gi * HEAD:(gi + 1) * HEAD]
        prev = jnp.pad(c, ((0, 0), (w - 1, 0), (0, 0)))[:, :T]
        mean = (c[:, 1:] - prev) / jnp.minimum(pos + 1.0, float(w))[None, :, None]
        groups.append(mean - uf[:, :, gi * HEAD:(gi + 1) * HEAD])
    d = jnp.stack(groups, axis=2)
    y = jnp.einsum('btgc,gcd->btgd', d, w_blk).reshape(B, T, GROUP_W) * scale
    return y.astype(u.dtype)


def rwkv7_mixer(p, mu, w0, w_up, a0, a_up, g_up, k_k, k_a, r_k, gn_g, gn_b, v_first, v_mix):
    B, T, _ = p.shape
    pm = p + (token_shift(p) - p) * mu
    r, k, v, wd, ad, gd = jnp.split(pm, RW_SPLITS, axis=-1)
    w = -jax.nn.softplus(-(w0 + jnp.tanh(wd) @ w_up)) - 0.5
    log_decay = -jnp.exp(w.astype(jnp.float32))
    a = jax.nn.sigmoid(a0 + ad @ a_up)
    g = jax.nn.sigmoid(gd) @ g_up
    if v_first is None:
        v_first = v
    else:
        v0, v_down, v_up = v_mix
        v = v + (v_first - v) * jax.nn.sigmoid(v0 + (v @ v_down) @ v_up)
    kk = split_heads(k * k_k)
    kk = kk * lax.rsqrt(jnp.sum(kk * kk, -1, keepdims=True) + 1e-12)
    k = k * (1.0 + (a - 1.0) * k_a)
    rh, kh, vh, ah = split_heads(r), split_heads(k), split_heads(v), split_heads(a)
    dh = jnp.exp(split_heads(log_decay))
    bvec = kk * ah
    xs = tuple(jnp.moveaxis(z, 1, 0) for z in (rh, dh, kh, vh, kk, bvec))

    def step(S, inp):
        r_t, d_t, k_t, v_t, kk_t, b_t = inp
        sa = jnp.einsum('bhvk,bhk->bhv', S, kk_t)
        S = S * d_t[:, :, None, :] - sa[..., None] * b_t[:, :, None, :] + v_t[..., None] * k_t[:, :, None, :]
        return S, jnp.einsum('bhvk,bhk->bhv', S, r_t)

    S0 = jnp.zeros((B, N_H, HEAD, HEAD), jnp.float32)
    _, y = lax.scan(step, S0, xs)
    y = head_norm(jnp.moveaxis(y, 0, 1), gn_g, gn_b)
    bonus = jnp.sum(rh * kh * r_k, -1, keepdims=True) * vh
    out = (y + bonus.reshape(B, T, GROUP_W)) * g
    return out.astype(p.dtype), v_first


def rglru_mixer(xb, gate, conv_w, conv_b, ga_w, ga_b, gx_w, gx_b, lam):
    B, T, _ = xb.shape
    xc = causal_dwconv(xb, conv_w, conv_b)
    xh = split_heads(xc)
    r = jax.nn.sigmoid(jnp.einsum('btgc,gcd->btgd', xh, ga_w).reshape(B, T, GROUP_W) + ga_b)
    i = jax.nn.sigmoid(jnp.einsum('btgc,gcd->btgd', xh, gx_w).reshape(B, T, GROUP_W) + gx_b)
    log_a = -LRU_C * r * jax.nn.softplus(-lam.astype(jnp.float32))
    a = jnp.exp(log_a)
    u = jnp.sqrt(-jnp.expm1(2.0 * log_a)) * (i * xc.astype(jnp.float32))

    def combine(lhs, rhs):
        return lhs[0] * rhs[0], rhs[0] * lhs[1] + rhs[1]

    _, h = lax.associative_scan(combine, (a, u), axis=1)
    return (h * jax.nn.gelu(gate.astype(jnp.float32))).astype(xb.dtype)


def mlstm_mixer(p, if_b, gn_g, gn_b):
    B, T, _ = p.shape
    L = ML_CHUNK
    pad = L - N_META
    Tp = T + pad
    NC = Tp // L
    pp = jnp.pad(p.astype(jnp.float32), ((0, 0), (pad, 0), (0, 0)))
    q, k, v, o, gates = jnp.split(pp, (GROUP_W, 2 * GROUP_W, 3 * GROUP_W, 4 * GROUP_W), axis=-1)

    def chunks(z):
        return z.reshape(B, NC, L, N_H, HEAD)

    q = chunks(q) * HEAD ** -0.5
    k = chunks(k)
    v = chunks(v)
    gates = (gates + if_b).reshape(B, NC, L, 2 * N_H)
    valid = (jnp.arange(Tp) >= pad).reshape(1, NC, L, 1)
    logi = jnp.where(valid, gates[..., :N_H], NEG)
    logf = jnp.where(valid, jax.nn.log_sigmoid(gates[..., N_H:]), 0.0)
    b = jnp.cumsum(logf, axis=2)
    causal = jnp.tril(jnp.ones((L, L), dtype=bool))[None, None, :, :, None]
    dmat = jnp.where(causal, b[:, :, :, None, :] - b[:, :, None, :, :] + logi[:, :, None, :, :], NEG)
    m_intra = jnp.max(dmat, axis=3)
    b_last = b[:, :, -1]
    g_loc = b_last[:, :, None] - b + logi
    m_loc = jnp.max(g_loc, axis=2)
    w_loc = jnp.exp(g_loc - m_loc[:, :, None])
    c_loc = jnp.einsum('bnlh,bnlhv,bnlhk->bnhvk', w_loc, v, k)
    n_loc = jnp.einsum('bnlh,bnlhk->bnhk', w_loc, k)

    def step(carry, inp):
        c_st, n_st, m_st = carry
        c_l, n_l, m_l, bl = inp
        m_new = jnp.maximum(bl + m_st, m_l)
        s_old = jnp.exp(bl + m_st - m_new)
        s_new = jnp.exp(m_l - m_new)
        c_new = s_old[..., None, None] * c_st + s_new[..., None, None] * c_l
        n_new = s_old[..., None] * n_st + s_new[..., None] * n_l
        return (c_new, n_new, m_new), (c_st, n_st, m_st)

    init = (jnp.zeros((B, N_H, HEAD, HEAD), jnp.float32), jnp.zeros((B, N_H, HEAD), jnp.float32),
            jnp.zeros((B, N_H), jnp.float32))
    xs = tuple(jnp.moveaxis(z, 1, 0) for z in (c_loc, n_loc, m_loc, b_last))
    _, (c_prev, n_prev, m_prev) = lax.scan(step, init, xs)
    c_prev = jnp.moveaxis(c_prev, 0, 1)
    n_prev = jnp.moveaxis(n_prev, 0, 1)
    m_prev = jnp.moveaxis(m_prev, 0, 1)
    m_inter = b + m_prev[:, :, None, :]
    m_t = jnp.maximum(m_intra, m_inter)
    s = jnp.einsum('bnthd,bnshd->bntsh', q, k) * jnp.exp(dmat - m_t[:, :, :, None, :])
    w_inter = jnp.exp(m_inter - m_t)
    num = jnp.einsum('bntsh,bnshv->bnthv', s, v) + w_inter[..., None] * jnp.einsum('bnhvk,bnthk->bnthv', c_prev, q)
    den = jnp.sum(s, axis=3) + w_inter * jnp.einsum('bnhk,bnthk->bnth', n_prev, q)
    hh = num / jnp.maximum(jnp.abs(den), jnp.exp(-m_t))[..., None]
    hh = hh.reshape(B, Tp, N_H, HEAD)[:, pad:]
    y = head_norm(hh, gn_g, gn_b) * jax.nn.sigmoid(o[:, pad:])
    return y.astype(p.dtype)


def setup_inputs(seed: int = 0) -> dict:
    key = jax.random.key(seed)
    ks = iter(jax.random.split(key, 64))

    def nrm(shape, scale):
        return scale * jax.random.normal(next(ks), shape, jnp.float32)

    def gain(shape):
        return 1.0 + nrm(shape, 0.02)

    dm1 = DEPTH - 1
    sig = jax.random.uniform(next(ks), (DEPTH, GROUP_W), jnp.float32, 0.9, 0.999) ** (1.0 / LRU_C)
    lru_lambda = jnp.log(sig) - jnp.log1p(-sig)
    ml_if_b = jnp.concatenate([nrm((DEPTH, N_H), 0.1) - 1.0,
                               jnp.broadcast_to(jnp.linspace(3.0, 6.0, N_H), (DEPTH, N_H)) + nrm((DEPTH, N_H), 0.1)], axis=-1)
    return {
        'x': nrm((BATCH, SEQ, D_MODEL), 1.0),
        'meta': nrm((N_META, D_MODEL), 1.0),
        'emb_ln_g': gain((D_MODEL,)),
        'emb_ln_b': nrm((D_MODEL,), 0.02),
        'w_in': nrm((DEPTH, D_MODEL, D_IN), D_MODEL ** -0.5),
        'w_out': nrm((DEPTH, D_MIX, D_MODEL), BETA * D_MIX ** -0.5),
        'pool_w': nrm((DEPTH, N_H, HEAD, HEAD), HEAD ** -0.5),
        'pool_scale': gain((DEPTH, GROUP_W)),
        'rw_mu': jax.random.uniform(next(ks), (DEPTH, RW_COLS), jnp.float32),
        'rw_w0': jax.random.uniform(next(ks), (DEPTH, GROUP_W), jnp.float32, -6.0, -1.0),
        'rw_w_up': nrm((DEPTH, RW_W_RANK, GROUP_W), 0.1),
        'rw_a0': nrm((DEPTH, GROUP_W), 0.1),
        'rw_a_up': nrm((DEPTH, RW_A_RANK, GROUP_W), RW_A_RANK ** -0.5),
        'rw_g_up': nrm((DEPTH, RW_G_RANK, GROUP_W), RW_G_RANK ** -0.5),
        'rw_k_k': 0.85 + nrm((DEPTH, GROUP_W), 0.05),
        'rw_k_a': 1.0 + nrm((DEPTH, GROUP_W), 0.05),
        'rw_r_k': nrm((DEPTH, N_H, HEAD), 0.1),
        'rw_gn_g': gain((DEPTH, GROUP_W)),
        'rw_gn_b': nrm((DEPTH, GROUP_W), 0.02),
        'rw_v0': nrm((dm1, GROUP_W), 0.1),
        'rw_v_down': nrm((dm1, GROUP_W, RW_V_RANK), GROUP_W ** -0.5),
        'rw_v_up': nrm((dm1, RW_V_RANK, GROUP_W), 0.1),
        'lru_conv_w': nrm((DEPTH, CONV_W, GROUP_W), CONV_W ** -0.5),
        'lru_conv_b': nrm((DEPTH, GROUP_W), 0.02),
        'lru_ga_w': nrm((DEPTH, N_H, HEAD, HEAD), HEAD ** -0.5),
        'lru_ga_b': nrm((DEPTH, GROUP_W), 0.1),
        'lru_gx_w': nrm((DEPTH, N_H, HEAD, HEAD), HEAD ** -0.5),
        'lru_gx_b': nrm((DEPTH, GROUP_W), 0.1),
        'lru_lambda': lru_lambda,
        'ml_if_b': ml_if_b,
        'ml_gn_g': gain((DEPTH, GROUP_W)),
        'ml_gn_b': nrm((DEPTH, GROUP_W), 0.02),
        'ln1_g': gain((DEPTH, D_MODEL)),
        'ln1_b': nrm((DEPTH, D_MODEL), 0.02),
        'ln2_g': gain((DEPTH, D_MODEL)),
        'ln2_b': nrm((DEPTH, D_MODEL), 0.02),
        'mlp_w1': nrm((DEPTH, D_MODEL, D_FF), D_MODEL ** -0.5),
        'mlp_w2': nrm((DEPTH, D_FF, D_MODEL), BETA * D_FF ** -0.5),
    }


def reference(x, meta, emb_ln_g, emb_ln_b, w_in, w_out, pool_w, pool_scale, rw_mu, rw_w0, rw_w_up,
              rw_a0, rw_a_up, rw_g_up, rw_k_k, rw_k_a, rw_r_k, rw_gn_g, rw_gn_b, rw_v0, rw_v_down,
              rw_v_up, lru_conv_w, lru_conv_b, lru_ga_w, lru_ga_b, lru_gx_w, lru_gx_b, lru_lambda,
              ml_if_b, ml_gn_g, ml_gn_b, ln1_g, ln1_b, ln2_g, ln2_b, mlp_w1, mlp_w2):
    B = x.shape[0]
    h = jnp.concatenate([jnp.broadcast_to(meta[None].astype(x.dtype), (B, N_META, D_MODEL)), x], axis=1)
    h = layer_norm(h, emb_ln_g, emb_ln_b)
    v_first = None
    for l in range(DEPTH):
        p = h @ w_in[l]
        p_pool, p_rw, p_lru_x, p_lru_g, p_ml = jnp.split(p, PROJ_SPLITS, axis=-1)
        y_pool = pool_mixer(p_pool, pool_w[l], pool_scale[l])
        v_mix = None if l == 0 else (rw_v0[l - 1], rw_v_down[l - 1], rw_v_up[l - 1])
        y_rw, v_first = rwkv7_mixer(p_rw, rw_mu[l], rw_w0[l], rw_w_up[l], rw_a0[l], rw_a_up[l], rw_g_up[l],
                                    rw_k_k[l], rw_k_a[l], rw_r_k[l], rw_gn_g[l], rw_gn_b[l], v_first, v_mix)
        y_lru = rglru_mixer(p_lru_x, p_lru_g, lru_conv_w[l], lru_conv_b[l], lru_ga_w[l], lru_ga_b[l],
                            lru_gx_w[l], lru_gx_b[l], lru_lambda[l])
        y_ml = mlstm_mixer(p_ml, ml_if_b[l], ml_gn_g[l], ml_gn_b[l])
        mix = jnp.concatenate([y_pool, y_rw, y_lru, y_ml], axis=-1) @ w_out[l]
        h = layer_norm(ALPHA * h + mix, ln1_g[l], ln1_b[l])
        ff = jnp.square(jax.nn.relu(h @ mlp_w1[l])) @ mlp_w2[l]
        h = layer_norm(ALPHA * h + ff, ln2_g[l], ln2_b[l])
    return h[:, N_META:]
```

```cpp
#include <hip/hip_runtime.h>
#include <hip/hip_cooperative_groups.h>
#include <cstdio>
#include <cstdint>
namespace cg = cooperative_groups;
namespace pg8 {
#define PG8_LAS __attribute__((address_space(3)))
typedef unsigned short bf16_t;
typedef short bf16x8 __attribute__((ext_vector_type(8)));
typedef float f32x4 __attribute__((ext_vector_type(4)));
typedef unsigned u32x4 __attribute__((ext_vector_type(4)));
constexpr int BM = 256, BK = 64, HALF = 128, HTB = HALF * BK * 2  , STAGE_BYTES = 8 * HTB, NXCD = 8, WGM = 4;

__host__ __device__ __forceinline__ int lds_byte(int r, int c) { const int st = (r >> 4) * 2 + (c >> 5), rr = r & 15, cc = c & 31, ob = rr * 64 + cc * 2; return st * 1024 + (ob ^ (((ob >> 9) & 1) << 5)); }
__host__ __device__ __forceinline__ void stage_rc(int b, int& R, int& C) { const int st = b / 1024, sb = b % 1024, swz = sb ^ (((sb >> 9) & 1) << 5); R = (st >> 1) * 16 + swz / 64; C = (st & 1) * 32 + (swz % 64) / 2; }
__host__ __device__ __forceinline__ int perm32(int rho) { const int n = rho >> 4, i = rho & 15; return 8 * (i >> 2) + 4 * n + (i & 3); }

struct Unit { int pm, pn; };
struct Gemm { const bf16_t* A; const bf16_t* Bt; int M, N, K; };

struct StaticOrder {
    int nM, nN, nwg, G, c;
    __host__ __device__ void init(int M, int N, int G_, int c_) { nM = M / BM; nN = N / BM; nwg = nM * nN; G = G_; c = c_; }
    __host__ __device__ bool next(int i, Unit& u) const {
        const long L = (long)i * G + c; if (L >= nwg) return false;
        int wgid = (int)L; { const int q = nwg / NXCD, r = nwg % NXCD, xcd = wgid % NXCD, off = wgid / NXCD; wgid = (xcd < r ? xcd * (q + 1) : r * (q + 1) + (xcd - r) * q) + off; }
        const int nig = WGM * nN, gid = wgid / nig, fm = gid * WGM, gsz = (nM - fm) < WGM ? (nM - fm) : WGM;
        u.pm = fm + ((wgid % nig) % gsz); u.pn = (wgid % nig) / gsz; return true;
    }
    __device__ __forceinline__ void a_ready(const Unit&) const {}
    __device__ __forceinline__ void done(const Unit&) const {}
};


__device__ __forceinline__ unsigned cvt_pk_bf16(float lo, float hi) { unsigned r; asm volatile("v_cvt_pk_bf16_f32 %0, %1, %2" : "=v"(r) : "v"(lo), "v"(hi)); return r; }
__device__ __forceinline__ float bflo(unsigned w) { return __builtin_bit_cast(float, w << 16); }
__device__ __forceinline__ float bfhi(unsigned w) { return __builtin_bit_cast(float, w & 0xffff0000u); }

template <int ACT> struct EpiStore {
    static constexpr bool PERM = true, AFTER_DRAIN = false;
    bf16_t* O; int ldc;
    __device__ __forceinline__ void operator()(const f32x4 (&acc)[2][2][4][2], const Unit& u, int wr, int wc, int fr, int fq) const {
        const int row0 = u.pm * BM + wr * 64 + fr; const int col0 = u.pn * BM + wc * 32 + 8 * fq;
#pragma unroll
        for (int ai = 0; ai < 2; ++ai)
#pragma unroll
            for (int m = 0; m < 4; ++m) { bf16_t* rowp = O + (size_t)(row0 + ai * HALF + m * 16) * ldc + col0;
#pragma unroll
                for (int bj = 0; bj < 2; ++bj) { f32x4 v0 = acc[ai][bj][m][0], v1 = acc[ai][bj][m][1];
                    if (ACT == 2) {
#pragma unroll
                        for (int q = 0; q < 4; ++q) { float a = v0[q] > 0.f ? v0[q] : 0.f; v0[q] = a * a; float b = v1[q] > 0.f ? v1[q] : 0.f; v1[q] = b * b; } }
                    u32x4 w; w.x = cvt_pk_bf16(v0[0], v0[1]); w.y = cvt_pk_bf16(v0[2], v0[3]); w.z = cvt_pk_bf16(v1[0], v1[1]); w.w = cvt_pk_bf16(v1[2], v1[3]);
                    *(u32x4*)(rowp + bj * HALF) = w; } }
    }
};
struct EpiResid {
    static constexpr bool PERM = true, AFTER_DRAIN = false;
    bf16_t* H; int ldc; float alpha;
    __device__ __forceinline__ void operator()(const f32x4 (&acc)[2][2][4][2], const Unit& u, int wr, int wc, int fr, int fq) const {
        const int row0 = u.pm * BM + wr * 64 + fr; const int col0 = u.pn * BM + wc * 32 + 8 * fq;
#pragma unroll
        for (int ai = 0; ai < 2; ++ai)
#pragma unroll
            for (int m = 0; m < 4; ++m) { bf16_t* rowp = H + (size_t)(row0 + ai * HALF + m * 16) * ldc + col0;
#pragma unroll
                for (int bj = 0; bj < 2; ++bj) { const f32x4 v0 = acc[ai][bj][m][0], v1 = acc[ai][bj][m][1];
                    const u32x4 o = *(const u32x4*)(rowp + bj * HALF);
                    u32x4 w;
                    w.x = cvt_pk_bf16(alpha * bflo(o.x) + v0[0], alpha * bfhi(o.x) + v0[1]);
                    w.y = cvt_pk_bf16(alpha * bflo(o.y) + v0[2], alpha * bfhi(o.y) + v0[3]);
                    w.z = cvt_pk_bf16(alpha * bflo(o.z) + v1[0], alpha * bfhi(o.z) + v1[1]);
                    w.w = cvt_pk_bf16(alpha * bflo(o.w) + v1[2], alpha * bfhi(o.w) + v1[3]);
                    *(u32x4*)(rowp + bj * HALF) = w; } }
    }
};

template <class Epi, class Sched, bool ALIGN_EPI = false, bool SP2 = false>
__device__ __forceinline__ void gemm_phase(PG8_LAS unsigned char* lds, const Gemm g, const Sched& S, const Epi& E) {
    int tid_o = threadIdx.x; asm volatile("" : "+v"(tid_o));
    const int tid = tid_o, wid = __builtin_amdgcn_readfirstlane(tid >> 6), lane = tid & 63, wr = wid >> 2, wc = wid & 3, fr = lane & 15, fq = lane >> 4;
    const int K = g.K, nt = K / BK;
    unsigned voffA[2], voffB[2];
#pragma unroll
    for (int i = 0; i < 2; ++i) { int R, C; stage_rc(tid * 16 + i * 8192, R, C); const int Rb = Epi::PERM ? ((R & ~31) + perm32(R & 31)) : R;
        voffA[i] = (unsigned)(R * K + C) * 2u; voffB[i] = (unsigned)(Rb * K + C) * 2u; }
    const size_t kstep = (size_t)(BK * 2);
    const size_t hstep = (size_t)HALF * K * 2;
    const size_t tstep = 2 * hstep;
    const unsigned ldsw = (unsigned)wid * 1024u;
    const int aoff = lds_byte(wr * 64 + fr, fq * 8), boff = lds_byte(wc * 32 + fr, fq * 8);
#define PG8_SA(b, h) (((b) * 2 + (h)) * HTB)
#define PG8_SB(b, h) ((4 + (b) * 2 + (h)) * HTB)
#define PG8_STAGE(bufoff, gbase, voff) do { _Pragma("unroll") for (int _i = 0; _i < 2; ++_i) \
        __builtin_amdgcn_global_load_lds((const unsigned*)((const char*)(gbase) + (voff)[_i]), (PG8_LAS unsigned*)(lds + (bufoff) + ldsw + _i * 8192), 16, 0, 0); } while (0)
#define PG8_LDA(dst, b, h) do { _Pragma("unroll") for (int m = 0; m < 4; ++m) _Pragma("unroll") for (int k = 0; k < 2; ++k) dst[m][k] = *(const PG8_LAS bf16x8*)(lds + PG8_SA(b, h) + aoff + m * 2048 + k * 1024); } while (0)
#define PG8_LDB(dst, b, h) do { _Pragma("unroll") for (int n = 0; n < 2; ++n) _Pragma("unroll") for (int k = 0; k < 2; ++k) dst[n][k] = *(const PG8_LAS bf16x8*)(lds + PG8_SB(b, h) + boff + n * 2048 + k * 1024); } while (0)
#define PG8_MMA(ai, bj, At, Bt) do { __builtin_amdgcn_s_setprio(1); _Pragma("unroll") for (int m = 0; m < 4; ++m) _Pragma("unroll") for (int n = 0; n < 2; ++n) _Pragma("unroll") for (int k = 0; k < 2; ++k) \
        acc[ai][bj][m][n] = __builtin_amdgcn_mfma_f32_16x16x32_bf16(Bt[n][k], At[m][k], acc[ai][bj][m][n], 0, 0, 0); __builtin_amdgcn_s_setprio(0); } while (0)
#define PG8_WAIT_V(n) asm volatile("s_waitcnt vmcnt(" #n ")" ::: "memory")
#define PG8_WAIT_L(n) asm volatile("s_waitcnt lgkmcnt(" #n ")" ::: "memory")
#define PG8_BAR __builtin_amdgcn_s_barrier()
#define PG8_SCHED __builtin_amdgcn_sched_barrier(0)
    Unit cur, nxt; int ui = 0;
    if (!S.next(0, cur)) return;
    f32x4 acc[2][2][4][2];
#pragma unroll
    for (int a = 0; a < 2; ++a)
#pragma unroll
        for (int b = 0; b < 2; ++b)
#pragma unroll
            for (int m = 0; m < 4; ++m)
#pragma unroll
                for (int n = 0; n < 2; ++n) acc[a][b][m][n] = (f32x4){0.f, 0.f, 0.f, 0.f};
    bf16x8 At[4][2], B0[2][2], B1[2][2];
    const char* cA = (const char*)g.A + (size_t)cur.pm * tstep; const char* cB = (const char*)g.Bt + (size_t)cur.pn * tstep;
    S.a_ready(cur);
    if constexpr (SP2) {
        PG8_STAGE(PG8_SB(0, 0), cB, voffB); PG8_STAGE(PG8_SB(0, 1), cB + hstep, voffB); PG8_STAGE(PG8_SA(0, 0), cA, voffA); PG8_STAGE(PG8_SA(0, 1), cA + hstep, voffA);
        if (wr == 1) PG8_BAR;
        PG8_WAIT_V(2); PG8_BAR;
        PG8_STAGE(PG8_SB(1, 0), cB + kstep, voffB); PG8_STAGE(PG8_SA(1, 0), cA + kstep, voffA); PG8_STAGE(PG8_SB(1, 1), cB + hstep + kstep, voffB);
        PG8_WAIT_V(6); PG8_BAR;
    } else {
        PG8_STAGE(PG8_SB(0, 0), cB, voffB); PG8_STAGE(PG8_SA(0, 0), cA, voffA); PG8_STAGE(PG8_SB(0, 1), cB + hstep, voffB); PG8_STAGE(PG8_SA(0, 1), cA + hstep, voffA);
        if (wr == 1) PG8_BAR;
        PG8_WAIT_V(4); PG8_BAR;
        PG8_STAGE(PG8_SB(1, 0), cB + kstep, voffB); PG8_STAGE(PG8_SA(1, 0), cA + kstep, voffA); PG8_STAGE(PG8_SB(1, 1), cB + hstep + kstep, voffB);
        PG8_WAIT_V(6); PG8_BAR;
    }
    for (;;) {
        const bool has_next = S.next(ui + 1, nxt);
        const char* nA = has_next ? (const char*)g.A + (size_t)nxt.pm * tstep : cA; const char* nB = has_next ? (const char*)g.Bt + (size_t)nxt.pn * tstep : cB;
        for (int t = 0; t < nt; t += 2) {
            const bool last = (t == nt - 2);
            const char* a1 = cA + (size_t)(t + 1) * kstep;
            const char* a2 = last ? nA : cA + (size_t)(t + 2) * kstep; const char* b2 = last ? nB : cB + (size_t)(t + 2) * kstep;
            const char* a3 = a2 + kstep; const char* b3 = b2 + kstep;
            if (last && has_next) S.a_ready(nxt);
            if constexpr (SP2) {
            PG8_LDB(B0, 0, 0); PG8_LDB(B1, 0, 1); PG8_SCHED; PG8_LDA(At, 0, 0); PG8_STAGE(PG8_SA(1, 1), a1 + hstep, voffA);
            PG8_WAIT_V(8); PG8_WAIT_L(0); PG8_BAR; PG8_MMA(0, 0, At, B0); PG8_MMA(0, 1, At, B1); PG8_BAR; PG8_SCHED;
            PG8_LDA(At, 0, 1); PG8_STAGE(PG8_SB(0, 0), b2, voffB); PG8_STAGE(PG8_SB(0, 1), b2 + hstep, voffB); PG8_STAGE(PG8_SA(0, 0), a2, voffA);
            PG8_WAIT_V(8); PG8_WAIT_L(0); PG8_BAR; PG8_MMA(1, 0, At, B0); PG8_MMA(1, 1, At, B1); PG8_BAR; PG8_SCHED;
            PG8_LDB(B0, 1, 0); PG8_LDB(B1, 1, 1); PG8_SCHED; PG8_LDA(At, 1, 0); PG8_STAGE(PG8_SA(0, 1), a2 + hstep, voffA);
            PG8_WAIT_V(8); PG8_WAIT_L(0); PG8_BAR; PG8_MMA(0, 0, At, B0); PG8_MMA(0, 1, At, B1); PG8_BAR; PG8_SCHED;
            PG8_LDA(At, 1, 1); PG8_STAGE(PG8_SB(1, 0), b3, voffB); PG8_STAGE(PG8_SB(1, 1), b3 + hstep, voffB); PG8_STAGE(PG8_SA(1, 0), a3, voffA);
            PG8_WAIT_V(8); PG8_WAIT_L(0); PG8_BAR; PG8_MMA(1, 0, At, B0); PG8_MMA(1, 1, At, B1); PG8_BAR; PG8_SCHED;
            } else {
            PG8_LDB(B0, 0, 0); PG8_SCHED; PG8_LDA(At, 0, 0); PG8_STAGE(PG8_SA(1, 1), a1 + hstep, voffA);
            PG8_WAIT_L(8); PG8_BAR; PG8_WAIT_L(0); PG8_MMA(0, 0, At, B0); PG8_BAR; PG8_SCHED;
            PG8_LDB(B1, 0, 1); PG8_STAGE(PG8_SB(0, 0), b2, voffB);
            PG8_BAR; PG8_WAIT_L(0); PG8_MMA(0, 1, At, B1); PG8_BAR;
            PG8_LDA(At, 0, 1); PG8_STAGE(PG8_SA(0, 0), a2, voffA);
            PG8_BAR; PG8_WAIT_L(0); PG8_MMA(1, 0, At, B0); PG8_BAR; PG8_SCHED;
            PG8_STAGE(PG8_SB(0, 1), b2 + hstep, voffB);
            PG8_WAIT_V(6); PG8_BAR; PG8_MMA(1, 1, At, B1); PG8_BAR;
            PG8_LDB(B0, 1, 0); PG8_SCHED; PG8_LDA(At, 1, 0); PG8_STAGE(PG8_SA(0, 1), a2 + hstep, voffA);
            PG8_WAIT_L(8); PG8_BAR; PG8_WAIT_L(0); PG8_MMA(0, 0, At, B0); PG8_BAR; PG8_SCHED;
            PG8_LDB(B1, 1, 1); PG8_STAGE(PG8_SB(1, 0), b3, voffB);
            PG8_BAR; PG8_WAIT_L(0); PG8_MMA(0, 1, At, B1); PG8_BAR;
            PG8_LDA(At, 1, 1); PG8_STAGE(PG8_SA(1, 0), a3, voffA);
            PG8_BAR; PG8_WAIT_L(0); PG8_MMA(1, 0, At, B0); PG8_BAR; PG8_SCHED;
            PG8_STAGE(PG8_SB(1, 1), b3 + hstep, voffB);
            PG8_WAIT_V(6); PG8_BAR; PG8_MMA(1, 1, At, B1); PG8_BAR;
            }
        }
        if constexpr (ALIGN_EPI) { if (wr == 0) PG8_BAR; }
        if constexpr (!Epi::AFTER_DRAIN) { E(acc, cur, wr, wc, fr, fq); S.done(cur); }
        if (!has_next) break;
#pragma unroll
        for (int a = 0; a < 2; ++a)
#pragma unroll
            for (int b = 0; b < 2; ++b)
#pragma unroll
                for (int m = 0; m < 4; ++m)
#pragma unroll
                    for (int n = 0; n < 2; ++n) acc[a][b][m][n] = (f32x4){0.f, 0.f, 0.f, 0.f};
        cur = nxt; cA = nA; cB = nB; ++ui;
        if constexpr (ALIGN_EPI) { if (wr == 1) PG8_BAR; }
    }
    PG8_WAIT_V(0);
    if constexpr (!ALIGN_EPI) { if (wr == 0) PG8_BAR; }
    PG8_BAR;
    if constexpr (Epi::AFTER_DRAIN) { E.fused(acc, cur, wr, wc, fr, fq, lds, wid, lane); S.done(cur); }
#undef PG8_SA
#undef PG8_SB
#undef PG8_STAGE
#undef PG8_LDA
#undef PG8_LDB
#undef PG8_MMA
#undef PG8_WAIT_V
#undef PG8_WAIT_L
#undef PG8_BAR
#undef PG8_SCHED
}
}

typedef unsigned short bf16;
typedef float f32x4 __attribute__((ext_vector_type(4)));
typedef unsigned u32x4 __attribute__((ext_vector_type(4)));
constexpr int NTHR = 512;
constexpr int NB = 2, SEQ = 16384, NMETA = 16, DM = 1024, DEPTH = 4;
constexpr int TP = 16448, PADT = 48, NCH = 257, MR = NB * TP, MP = 33024;
constexpr int DIN = 2696, DINP = 2816, FF = 4096, GWD = 256;
constexpr int MMAIN = NB * SEQ;
constexpr float ALPHA = 1.6817928305074292f;
constexpr float LN_EPS = 1e-5f, GN_EPS = 64e-5f;
constexpr int PC_POOL = 0, PC_RW = 256, PC_LX = 1152, PC_LG = 1408, PC_MQ = 1664, PC_MK = 1920, PC_MV = 2176, PC_MO = 2432, PC_MI = 2688, PC_MF = 2692;
constexpr size_t LW_IN = 0, LW_OUT = (size_t)DINP * DM * 2, LW_1 = LW_OUT + (size_t)DM * DM * 2, LW_2 = LW_1 + (size_t)FF * DM * 2, LW_SZ = LW_2 + (size_t)DM * FF * 2;
constexpr size_t WS_W = 0;
constexpr size_t WS_HB = WS_W + 4 * LW_SZ;
constexpr size_t WS_U = WS_HB + (size_t)MP * DM * 2;
constexpr size_t U_P = 0, U_MIX = (size_t)MP * DINP * 2, U_ACG = U_MIX + (size_t)MP * DM * 2, U_SZ = (size_t)MP * FF * 2;
static_assert(U_ACG + (size_t)MP * GWD * 2 <= U_SZ, "U map");
constexpr size_t WS_LRUA = WS_U + U_SZ;
constexpr size_t WS_LRUH = WS_LRUA + (size_t)NB * NCH * GWD * 4;
constexpr size_t WS_LRUS = WS_LRUH + (size_t)NB * NCH * GWD * 4;
constexpr size_t WS_MLN = WS_LRUS + (size_t)NB * NCH * GWD * 4;
constexpr size_t WS_MLM = WS_MLN + (size_t)NB * NCH * 4 * 64 * 4;
constexpr size_t WS_MLB = WS_MLM + (size_t)NB * NCH * 4 * 4;
constexpr size_t WS_MLP = WS_MLB + (size_t)NB * NCH * 4 * 4;
constexpr size_t WS_LORA = (WS_MLP + (size_t)NB * NCH * 4 * 4 + 255) / 256 * 256;
constexpr size_t WS_WT3 = (WS_LORA + (size_t)514 * 64 * 256 * 8 + 255) / 256 * 256;
constexpr size_t WS_WT4 = WS_WT3 + (size_t)DEPTH * 3 * 4 * 4096 * 2;
constexpr size_t WS_PAR = WS_WT4 + (size_t)DEPTH * 49152 * 2;
constexpr int PAR_TOTAL = 416032;
constexpr size_t WS_BAR = (WS_PAR + (size_t)PAR_TOTAL * 4 + 255) / 256 * 256;
constexpr size_t BAR_BYTES = 16384;
constexpr size_t WS_END = WS_BAR + BAR_BYTES;
constexpr size_t DO_VF = 0;
constexpr size_t DO_RWP = DO_VF + (size_t)MP * GWD * 2;
constexpr size_t DO_RWS = DO_RWP + (size_t)NB * NCH * 4 * 4096 * 4;
constexpr size_t DO_MLC = DO_RWS + (size_t)NB * NCH * 4 * 4096 * 4;
constexpr size_t DO_END = DO_MLC + (size_t)NB * NCH * 4 * 4096 * 4;
static_assert(DO_END <= (size_t)NB * SEQ * DM * 4, "d_out scratch");
constexpr int LDS_BYTES = 147456;
#ifndef PB_REP
#define PB_REP 1
#endif
#ifndef PD_REP
#define PD_REP 1
#endif

struct Args { const float* in[38]; float* out; unsigned char* ws; };

__device__ __forceinline__ unsigned f2bf(float f) { unsigned u = __builtin_bit_cast(unsigned, f); return (u + 0x7fffu + ((u >> 16) & 1u)) >> 16; }
__device__ __forceinline__ unsigned pk2(float lo, float hi) { return f2bf(lo) | (f2bf(hi) << 16); }
__device__ __forceinline__ float bf2f(bf16 v) { return __builtin_bit_cast(float, (unsigned)v << 16); }
__device__ __forceinline__ float row16_sum(float v) {
#define WS_DPP(ctrl) { const int t_ = __builtin_amdgcn_update_dpp(0, __builtin_bit_cast(int, v), ctrl, 0xf, 0xf, false); v += __builtin_bit_cast(float, t_); }
    WS_DPP(0xB1) WS_DPP(0x4E) WS_DPP(0x141) WS_DPP(0x140)
#undef WS_DPP
    return v;
}
__device__ __forceinline__ float wave_sum(float v) {
#define WS_DPP(ctrl, rmask) { const int t_ = __builtin_amdgcn_update_dpp(0, __builtin_bit_cast(int, v), ctrl, rmask, 0xf, false); v += __builtin_bit_cast(float, t_); }
    WS_DPP(0xB1, 0xf) WS_DPP(0x4E, 0xf) WS_DPP(0x141, 0xf) WS_DPP(0x140, 0xf) WS_DPP(0x142, 0xa) WS_DPP(0x143, 0xc)
#undef WS_DPP
    return __builtin_bit_cast(float, __builtin_amdgcn_readlane(__builtin_bit_cast(int, v), 63));
}
__device__ __forceinline__ float frcp_(float x) { return __builtin_amdgcn_rcpf(x); }
__device__ __forceinline__ float frsq_(float x) { return __builtin_amdgcn_rsqf(x); }
__device__ __forceinline__ float sigmoidf_(float x) { return frcp_(1.f + __expf(-x)); }
__device__ __forceinline__ float tanhf_(float x) { return 1.f - 2.f * frcp_(__expf(2.f * x) + 1.f); }
__device__ __forceinline__ float softplusf_(float x) { return fmaxf(x, 0.f) + __logf(1.f + __expf(-fabsf(x))); }
__device__ __forceinline__ float logsigmoidf_(float x) { return fminf(x, 0.f) - __logf(1.f + __expf(-fabsf(x))); }
__device__ __forceinline__ float gelu_tanh(float x) { return 0.5f * x * (1.f + tanhf_(0.7978845608028654f * (x + 0.044715f * x * x * x))); }
#define LDS_WAIT() asm volatile("s_waitcnt lgkmcnt(0)" ::: "memory")

__device__ __forceinline__ void transpose_item(const float* W, int K, int N, int NP, bf16* WT, float* scr, int item, int lane) {
    const int nblk = NP / 32, kb = item / nblk, nb = item % nblk, k0 = 64 * kb, n0 = 32 * nb;
#pragma unroll 8
    for (int i = 0; i < 32; ++i) { const int kk = 2 * i + (lane >> 5); const int n = n0 + (lane & 31); scr[kk * 33 + (lane & 31)] = (n < N) ? W[(size_t)(k0 + kk) * N + n] : 0.f; }
    LDS_WAIT(); asm volatile("" ::: "memory");
    const int c = lane & 7;
#pragma unroll
    for (int j = 0; j < 4; ++j) { const int n = (lane >> 3) + 8 * j; const float* s = scr + (8 * c) * 33 + n;
        u32x4 o; o.x = pk2(s[0 * 33], s[1 * 33]); o.y = pk2(s[2 * 33], s[3 * 33]); o.z = pk2(s[4 * 33], s[5 * 33]); o.w = pk2(s[6 * 33], s[7 * 33]);
        *(u32x4*)(WT + (size_t)(n0 + n) * K + k0 + 8 * c) = o; }
    LDS_WAIT(); asm volatile("" ::: "memory");
}
__device__ __forceinline__ void ln_row_f32_to_bf16(const float* xrow, const float* g, const float* bb, bf16* orow, int lane) {
    const f32x4* xr = (const f32x4*)xrow + lane;
    f32x4 v[4]; float s = 0.f;
#pragma unroll
    for (int j = 0; j < 4; ++j) { v[j] = xr[64 * j]; s += (v[j].x + v[j].y) + (v[j].z + v[j].w); }
    const float mean = wave_sum(s) * (1.f / DM); float s2 = 0.f;
#pragma unroll
    for (int j = 0; j < 4; ++j) { v[j] = v[j] - mean; s2 += (v[j].x * v[j].x + v[j].y * v[j].y) + (v[j].z * v[j].z + v[j].w * v[j].w); }
    const float rstd = 1.f / sqrtf(wave_sum(s2) * (1.f / DM) + LN_EPS);
    unsigned long long* o8 = (unsigned long long*)orow + lane;
#pragma unroll
    for (int j = 0; j < 4; ++j) { const f32x4 gg = ((const f32x4*)g)[lane + 64 * j], b4 = ((const f32x4*)bb)[lane + 64 * j];
        const f32x4 y = v[j] * rstd * gg + b4;
        o8[64 * j] = (unsigned long long)pk2(y.x, y.y) | ((unsigned long long)pk2(y.z, y.w) << 32); }
}
__device__ __forceinline__ void ln_row_bf16(bf16* hrow, const float* g, const float* bb, float* outrow, int lane) {
    float v[16]; float s = 0.f;
#pragma unroll
    for (int j = 0; j < 2; ++j) { const u32x4 w = *((const u32x4*)(hrow + 512 * j) + lane);
        v[8 * j + 0] = pg8::bflo(w.x); v[8 * j + 1] = pg8::bfhi(w.x); v[8 * j + 2] = pg8::bflo(w.y); v[8 * j + 3] = pg8::bfhi(w.y);
        v[8 * j + 4] = pg8::bflo(w.z); v[8 * j + 5] = pg8::bfhi(w.z); v[8 * j + 6] = pg8::bflo(w.w); v[8 * j + 7] = pg8::bfhi(w.w); }
#pragma unroll
    for (int i = 0; i < 16; ++i) s += v[i];
    const float mean = wave_sum(s) * (1.f / DM); float s2 = 0.f;
#pragma unroll
    for (int i = 0; i < 16; ++i) { v[i] -= mean; s2 += v[i] * v[i]; }
    const float rstd = 1.f / sqrtf(wave_sum(s2) * (1.f / DM) + LN_EPS);
#pragma unroll
    for (int j = 0; j < 2; ++j) {
        const int c0 = 512 * j + 8 * lane;
        const f32x4 g0 = *(const f32x4*)(g + c0), g1 = *(const f32x4*)(g + c0 + 4), b0 = *(const f32x4*)(bb + c0), b1 = *(const f32x4*)(bb + c0 + 4);
        f32x4 y0, y1;
#pragma unroll
        for (int q = 0; q < 4; ++q) { y0[q] = v[8 * j + q] * rstd * g0[q] + b0[q]; y1[q] = v[8 * j + 4 + q] * rstd * g1[q] + b1[q]; }
        if (outrow) { *(f32x4*)(outrow + c0) = y0; *(f32x4*)(outrow + c0 + 4) = y1; }
        else { u32x4 w; w.x = pk2(y0[0], y0[1]); w.y = pk2(y0[2], y0[3]); w.z = pk2(y1[0], y1[1]); w.w = pk2(y1[2], y1[3]); *((u32x4*)(hrow + c0)) = w; }
    }
}

template <int MODE>
__device__ __forceinline__ void ml_gates(const bf16* p, const float* ifb, int l, int row0, int tv0, int bc_idx, float* li, float* bc, float* wl, float* mt, float* wint,
                                         float* g_mloc, float* g_blast, const float* g_mprev, int tid) {
    if (tid < 256) { const int h = tid >> 6, t = tid & 63; const bool valid = t >= tv0;
        const float gi = bf2f(p[(size_t)(row0 + t) * DINP + PC_MI + h]) + ifb[l * 8 + h];
        const float gf = bf2f(p[(size_t)(row0 + t) * DINP + PC_MF + h]) + ifb[l * 8 + 4 + h];
        const float liv = valid ? gi : -1e30f; float cum = valid ? logsigmoidf_(gf) : 0.f;
#pragma unroll
        for (int o = 1; o < 64; o <<= 1) { const float v = __shfl_up(cum, o); if (t >= o) cum += v; }
        li[t * 4 + h] = liv; bc[t * 4 + h] = cum;
        if (MODE == 1) {
            const float blast = __builtin_bit_cast(float, __builtin_amdgcn_readlane(__builtin_bit_cast(int, cum), 63)); const float gl = blast - cum + liv; float mloc = gl;
#pragma unroll
            for (int o = 1; o < 64; o <<= 1) mloc = fmaxf(mloc, __shfl_xor(mloc, o));
            wl[t * 4 + h] = __expf(gl - mloc);
            if (t == 0) { g_mloc[bc_idx * 4 + h] = mloc; g_blast[bc_idx * 4 + h] = blast; }
        } else {
            const float mprev = (tv0 > 0) ? 0.f : g_mprev[bc_idx * 4 + h]; float rm = liv - cum;
#pragma unroll
            for (int o = 1; o < 64; o <<= 1) { const float v = __shfl_up(rm, o); if (t >= o) rm = fmaxf(rm, v); }
            const float mintra = cum + rm, minter = cum + mprev, m = fmaxf(mintra, minter);
            mt[t * 4 + h] = m; wint[t * 4 + h] = __expf(minter - m);
        }
    }
    __syncthreads();
}

constexpr int WT4_AUP = 8192, WT4_VUP = 16384, WT4_GUP = 24576, WT4_VDT = 40960, WT4_SZ = 49152;
template <int MODE>
__device__ __forceinline__ void rw_lora(const Args& a, const bf16* p, bf16* LO, float* Lf, int l_in, int c, int row0, int hrb, int tid_in) {
    typedef short bf16x8 __attribute__((ext_vector_type(8)));
    typedef unsigned u32x2_ __attribute__((ext_vector_type(2)));
    int l = __builtin_amdgcn_readfirstlane(l_in); asm volatile("" : "+s"(l));
    int tid = tid_in; asm volatile("" : "+v"(tid));
    bf16* VPb = (bf16*)Lf; bf16* TWb = VPb + 64 * 264; bf16* ADb = TWb + 64 * 40; bf16* SGb = ADb + 64 * 40; bf16* VDb = SGb + 64 * 72;
    const float* mu = a.in[8] + l * 896;
    const bf16* wt4 = (const bf16*)(a.ws + WS_WT4) + (size_t)l * WT4_SZ;
    {
        u32x4 cur[6], prv[6];
#pragma unroll
        for (int i = 0; i < 6; ++i) { const int idx = tid + NTHR * i, t = idx / 48, c8 = idx % 48; const bf16* src = p + (size_t)(row0 + t) * DINP + PC_RW + 512 + c8 * 8;
            cur[i] = *(const u32x4*)src; prv[i] = (u32x4){0u, 0u, 0u, 0u}; if (64 * c + t - 1 >= PADT) prv[i] = (t > 0) ? *(const u32x4*)(src - DINP) : *(const u32x4*)(p + (size_t)(hrb - 1) * DINP + PC_RW + 512 + c8 * 8); }
#pragma unroll
        for (int i = 0; i < 6; ++i) { const int idx = tid + NTHR * i, t = idx / 48, c8 = idx % 48, col = 512 + c8 * 8;
            const float cf[8] = {pg8::bflo(cur[i].x), pg8::bfhi(cur[i].x), pg8::bflo(cur[i].y), pg8::bfhi(cur[i].y), pg8::bflo(cur[i].z), pg8::bfhi(cur[i].z), pg8::bflo(cur[i].w), pg8::bfhi(cur[i].w)};
            const float pf[8] = {pg8::bflo(prv[i].x), pg8::bfhi(prv[i].x), pg8::bflo(prv[i].y), pg8::bfhi(prv[i].y), pg8::bflo(prv[i].z), pg8::bfhi(prv[i].z), pg8::bflo(prv[i].w), pg8::bfhi(prv[i].w)};
            const f32x4 m0 = *(const f32x4*)(mu + col), m1 = *(const f32x4*)(mu + col + 4);
            float pm[8];
#pragma unroll
            for (int q = 0; q < 4; ++q) { pm[q] = cf[q] + (pf[q] - cf[q]) * m0[q]; pm[4 + q] = cf[4 + q] + (pf[4 + q] - cf[4 + q]) * m1[q]; }
            bf16* dst;
            if (c8 < 32) { dst = VPb + t * 264 + c8 * 8; }
            else if (c8 < 36) { dst = TWb + t * 40 + (c8 - 32) * 8;
#pragma unroll
                for (int q = 0; q < 8; ++q) pm[q] = tanhf_(pm[q]); }
            else if (c8 < 40) { dst = ADb + t * 40 + (c8 - 36) * 8; }
            else { dst = SGb + t * 72 + (c8 - 40) * 8;
#pragma unroll
                for (int q = 0; q < 8; ++q) pm[q] = sigmoidf_(pm[q]); }
            u32x4 o; o.x = pk2(pm[0], pm[1]); o.y = pk2(pm[2], pm[3]); o.z = pk2(pm[4], pm[5]); o.w = pk2(pm[6], pm[7]);
            *(u32x4*)dst = o; }
    }
    __syncthreads();
    const int lane = tid & 63, wv_ = __builtin_amdgcn_readfirstlane(tid >> 6), r = lane & 15, g = lane >> 4;
    if (l > 0) {
        const int tt = wv_ & 3, jt = wv_ >> 2; f32x4 acc = {0.f, 0.f, 0.f, 0.f};
#pragma unroll
        for (int kk = 0; kk < 8; ++kk) { const bf16x8 fa = *(const bf16x8*)(wt4 + WT4_VDT + (16 * jt + r) * 256 + 32 * kk + 8 * g), fb = *(const bf16x8*)(VPb + (16 * tt + r) * 264 + 32 * kk + 8 * g);
            acc = __builtin_amdgcn_mfma_f32_16x16x32_bf16(fa, fb, acc, 0, 0, 0); }
        u32x2_ o; o.x = pk2(acc[0], acc[1]); o.y = pk2(acc[2], acc[3]);
        *(u32x2_*)(VDb + (16 * tt + r) * 40 + 16 * jt + 4 * g) = o;
        __syncthreads();
    }
    {
        const int ch0 = 32 * wv_;
#pragma unroll
        for (int ct = 0; ct < 2; ++ct) { const int chr = ch0 + 16 * ct + r;
            const bf16x8 wu = *(const bf16x8*)(wt4 + chr * 32 + 8 * g), au = *(const bf16x8*)(wt4 + WT4_AUP + chr * 32 + 8 * g), vu = *(const bf16x8*)(wt4 + WT4_VUP + chr * 32 + 8 * g);
            const bf16x8 gu0 = *(const bf16x8*)(wt4 + WT4_GUP + chr * 64 + 8 * g), gu1 = *(const bf16x8*)(wt4 + WT4_GUP + chr * 64 + 32 + 8 * g);
#pragma unroll
            for (int tt = 0; tt < 4; ++tt) { const int t = 16 * tt + r; const f32x4 z4 = {0.f, 0.f, 0.f, 0.f};
                const bf16x8 bt = *(const bf16x8*)(TWb + t * 40 + 8 * g), ba = *(const bf16x8*)(ADb + t * 40 + 8 * g), bg0 = *(const bf16x8*)(SGb + t * 72 + 8 * g), bg1 = *(const bf16x8*)(SGb + t * 72 + 32 + 8 * g);
                const f32x4 dW = __builtin_amdgcn_mfma_f32_16x16x32_bf16(wu, bt, z4, 0, 0, 0), dA = __builtin_amdgcn_mfma_f32_16x16x32_bf16(au, ba, z4, 0, 0, 0);
                f32x4 dV = z4; if (l > 0) { const bf16x8 bv = *(const bf16x8*)(VDb + t * 40 + 8 * g); dV = __builtin_amdgcn_mfma_f32_16x16x32_bf16(vu, bv, z4, 0, 0, 0); }
                f32x4 dG = __builtin_amdgcn_mfma_f32_16x16x32_bf16(gu0, bg0, z4, 0, 0, 0); dG = __builtin_amdgcn_mfma_f32_16x16x32_bf16(gu1, bg1, dG, 0, 0, 0);
                u32x4 o0, o1; o0.x = pk2(dW[0], dA[0]); o0.y = pk2(dV[0], dG[0]); o0.z = pk2(dW[1], dA[1]); o0.w = pk2(dV[1], dG[1]);
                o1.x = pk2(dW[2], dA[2]); o1.y = pk2(dV[2], dG[2]); o1.z = pk2(dW[3], dA[3]); o1.w = pk2(dV[3], dG[3]);
                u32x4* dst = (u32x4*)(LO + ((size_t)t * 256 + ch0 + 16 * ct + 4 * g) * 4); dst[0] = o0; dst[1] = o1; } }
    }
    __syncthreads();
}

struct RwLds { float *R, *Dd, *Kp, *Vp, *KK, *Bv, *G, *bsum, *raw; };
template <int MODE>
__device__ __forceinline__ void rw_prep(const Args& a, const bf16* p, bf16* vfirst, const bf16* LO, const RwLds& L, int l, int c, int row0, int hrb, int ts, int tid) {
    const float* mu = a.in[8] + l * 896;
    const int ch = tid & 255, th = tid >> 8, lane = tid & 63, head = ch >> 6;
    typedef unsigned u32x2 __attribute__((ext_vector_type(2)));
    u32x2 lo[4]; float vf[4] = {0.f, 0.f, 0.f, 0.f};
    { u32x4 v[2];
#pragma unroll
      for (int i = 0; i < 2; ++i) { const int idx = tid + NTHR * i, rr = idx / 96, c8 = idx % 96, tl = ts - 1 + rr; const bool ok = (idx < 9 * 96) && (64 * c + tl >= PADT);
          v[i] = (u32x4){0u, 0u, 0u, 0u}; if (ok) v[i] = *(const u32x4*)(p + (size_t)(tl < 0 ? hrb + tl : row0 + tl) * DINP + PC_RW + c8 * 8); }
#pragma unroll
      for (int i = 0; i < 4; ++i) { lo[i] = *(const u32x2*)(LO + ((size_t)(ts + th * 4 + i) * 256 + ch) * 4); if (l > 0) vf[i] = bf2f(vfirst[(size_t)(row0 + ts + th * 4 + i) * 256 + ch]); }
#pragma unroll
      for (int i = 0; i < 2; ++i) { const int idx = tid + NTHR * i; if (idx < 9 * 96) {
          const f32x4 f0 = {pg8::bflo(v[i].x), pg8::bfhi(v[i].x), pg8::bflo(v[i].y), pg8::bfhi(v[i].y)}, f1 = {pg8::bflo(v[i].z), pg8::bfhi(v[i].z), pg8::bflo(v[i].w), pg8::bfhi(v[i].w)};
          *(f32x4*)&L.raw[idx * 8] = f0; *(f32x4*)&L.raw[idx * 8 + 4] = f1; } } }
    __syncthreads();
    const float w0 = a.in[9][l * 256 + ch], a0 = a.in[11][l * 256 + ch], kkc = a.in[14][l * 256 + ch], kac = a.in[15][l * 256 + ch], rkc = a.in[16][l * 256 + ch];
    const float v0 = (l > 0) ? a.in[19][(l - 1) * 256 + ch] : 0.f;
    const float mur = mu[ch], muk = mu[256 + ch], muv = mu[512 + ch];
#pragma unroll
    for (int i = 0; i < 4; ++i) { const int t = th * 4 + i, tl = ts + t; const size_t row = (size_t)(row0 + tl);
        const float rc = L.raw[(t + 1) * 768 + ch], rp = L.raw[t * 768 + ch], kc = L.raw[(t + 1) * 768 + 256 + ch], kp_ = L.raw[t * 768 + 256 + ch], vc = L.raw[(t + 1) * 768 + 512 + ch], vp_ = L.raw[t * 768 + 512 + ch];
        const float r = rc + (rp - rc) * mur, k = kc + (kp_ - kc) * muk; float v = vc + (vp_ - vc) * muv;
        const float aw = pg8::bflo(lo[i].x), aa = pg8::bfhi(lo[i].x), av = pg8::bflo(lo[i].y), ag = pg8::bfhi(lo[i].y);
        const float w = -softplusf_(-(w0 + aw)) - 0.5f; const float d = __expf(-__expf(w));
        const float av_ = sigmoidf_(a0 + aa);
        if (l == 0) { if (MODE == 1) vfirst[row * 256 + ch] = (bf16)f2bf(v); }
        else { v = v + (vf[i] - v) * sigmoidf_(v0 + av); }
        float kk = k * kkc; const float ss = wave_sum(kk * kk); kk = kk * (1.f / sqrtf(ss + 1e-12f));
        const float kp = k * (1.f + (av_ - 1.f) * kac);
        L.R[t * 256 + ch] = r; L.Dd[t * 256 + ch] = d; L.Kp[t * 256 + ch] = kp; L.Vp[t * 256 + ch] = v; L.KK[t * 256 + ch] = kk; L.Bv[t * 256 + ch] = kk * av_;
        if (MODE == 3) { L.G[t * 256 + ch] = ag; const float bs = wave_sum(r * kp * rkc); if (lane == 0) L.bsum[t * 4 + head] = bs; }
    }
    __syncthreads();
}

constexpr int WY_RS = 264  , WY_TS = 40  , WY_RH = 20  ;
constexpr int WY_AROW = 0, WY_BROW = 8448, WY_KROW = 16896, WY_PROW = 25344, WY_BKT = 33792, WY_UV = 54272, WY_VP = 74752, WY_G = 91136, WY_G16 = 107520, WY_BSUM = 108544, WY_SCR = 108800, WY_WSCR = 8704, WY_UVB = 20480;
static_assert(WY_SCR + 4 * WY_WSCR <= 147392, "WY LDS map");
typedef short wy_bf16x8 __attribute__((ext_vector_type(8)));
typedef unsigned wy_u32x2 __attribute__((ext_vector_type(2)));
template <int MODE>
__device__ __forceinline__ void wy_prep(const Args& a, const bf16* p, bf16* vfirst, const bf16* LO, unsigned char* lb, int l, int c, int row0, int hrb, int ts, int tid_in) {
    int tid = tid_in; asm volatile("" : "+v"(tid));
    const float* mu = a.in[8] + l * 896;
    const int ch = tid & 255, th = tid >> 8, lane = tid & 63, head = ch >> 6;
    bf16* rawb = (bf16*)(lb + WY_SCR);
    wy_u32x2 lo[8]; float vf[8];
    { u32x4 v[4];
#pragma unroll
      for (int i = 0; i < 4; ++i) { const int idx = tid + NTHR * i, rr = idx / 96, c8 = idx % 96, tl = ts - 1 + rr; const bool ok = (idx < 17 * 96) && (64 * c + tl >= PADT);
          v[i] = (u32x4){0u, 0u, 0u, 0u}; if (ok) v[i] = *(const u32x4*)(p + (size_t)(tl < 0 ? hrb + tl : row0 + tl) * DINP + PC_RW + c8 * 8); }
#pragma unroll
      for (int i = 0; i < 8; ++i) { lo[i] = *(const wy_u32x2*)(LO + ((size_t)(ts + th * 8 + i) * 256 + ch) * 4); vf[i] = (l > 0) ? bf2f(vfirst[(size_t)(row0 + ts + th * 8 + i) * 256 + ch]) : 0.f; }
#pragma unroll
      for (int i = 0; i < 4; ++i) { const int idx = tid + NTHR * i; if (idx < 17 * 96) *(u32x4*)(rawb + idx * 8) = v[i]; } }
    __syncthreads();
    const float w0 = a.in[9][l * 256 + ch], a0 = a.in[11][l * 256 + ch], kkc = a.in[14][l * 256 + ch], kac = a.in[15][l * 256 + ch], rkc = a.in[16][l * 256 + ch];
    const float v0 = (l > 0) ? a.in[19][(l - 1) * 256 + ch] : 0.f;
    const float mur = mu[ch], muk = mu[256 + ch], muv = mu[512 + ch];
    float* Vp = (float*)(lb + WY_VP); float* Gt = (float*)(lb + WY_G); float* bsum = (float*)(lb + WY_BSUM); float* g16 = (float*)(lb + WY_G16);
    bf16* UV = (bf16*)(lb + WY_UV);
    bf16* Ar = (bf16*)(lb + WY_AROW); bf16* Br = (bf16*)(lb + WY_BROW); bf16* Kr = (bf16*)(lb + WY_KROW); bf16* Pr = (bf16*)(lb + WY_PROW); bf16* BKT = (bf16*)(lb + WY_BKT);
    float cum = 0.f;
    if (th == 1) {
#pragma unroll
        for (int i = 0; i < 8; ++i) { const wy_u32x2 l0 = *(const wy_u32x2*)(LO + ((size_t)(ts + i) * 256 + ch) * 4); cum -= __expf(-softplusf_(-(w0 + pg8::bflo(l0.x))) - 0.5f); } }
    float eprev = __expf(cum);
    unsigned pkb[4], pkk[4], pkv[4];
#pragma unroll
    for (int i = 0; i < 8; ++i) { const int t = th * 8 + i; const size_t row = (size_t)(row0 + ts + t);
        const float rc = bf2f(rawb[(t + 1) * 768 + ch]), rp = bf2f(rawb[t * 768 + ch]), kc = bf2f(rawb[(t + 1) * 768 + 256 + ch]), kp_ = bf2f(rawb[t * 768 + 256 + ch]), vc = bf2f(rawb[(t + 1) * 768 + 512 + ch]), vp_ = bf2f(rawb[t * 768 + 512 + ch]);
        const float r = rc + (rp - rc) * mur, k = kc + (kp_ - kc) * muk; float v = vc + (vp_ - vc) * muv;
        const float aw = pg8::bflo(lo[i].x), aa = pg8::bfhi(lo[i].x), av = pg8::bflo(lo[i].y), ag = pg8::bfhi(lo[i].y);
        const float w = -softplusf_(-(w0 + aw)) - 0.5f; const float lgd = -__expf(w);
        const float av_ = sigmoidf_(a0 + aa);
        if (l == 0) { if (MODE == 1) vfirst[row * 256 + ch] = (bf16)f2bf(v); }
        else { v = v + (vf[i] - v) * sigmoidf_(v0 + av); }
        float kk = k * kkc; const float ss = wave_sum(kk * kk); kk = kk * frsq_(ss + 1e-12f);
        const float kp = k * (1.f + (av_ - 1.f) * kac);
        cum += lgd; const float ep = __expf(cum), en = frcp_(ep);
        const unsigned al = f2bf(kk * eprev), be = f2bf(kk * av_ * en), ka = f2bf(kp * en), rh = f2bf(r * ep); eprev = ep;
        Ar[t * WY_RS + ch] = (bf16)al; Br[t * WY_RS + ch] = (bf16)be; Kr[t * WY_RS + ch] = (bf16)ka; if (MODE == 3) Pr[t * WY_RS + ch] = (bf16)rh;
        { const unsigned nb = be ^ 0x8000u, vb_ = f2bf(v); if (i & 1) { pkb[i >> 1] |= nb << 16; pkk[i >> 1] |= ka << 16; pkv[i >> 1] |= vb_ << 16; } else { pkb[i >> 1] = nb; pkk[i >> 1] = ka; pkv[i >> 1] = vb_; } }
        if (MODE == 3) Vp[t * 256 + ch] = v;
        if (MODE == 3) { Gt[t * 256 + ch] = ag; const float bs = wave_sum(r * kp * rkc); if (lane == 0) bsum[t * 4 + head] = bs; }
    }
    { u32x4 w; w.x = pkb[0]; w.y = pkb[1]; w.z = pkb[2]; w.w = pkb[3]; *(u32x4*)(BKT + ch * WY_TS + th * 8) = w;
      w.x = pkk[0]; w.y = pkk[1]; w.z = pkk[2]; w.w = pkk[3]; *(u32x4*)(BKT + ch * WY_TS + 16 + th * 8) = w;
      w.x = pkv[0]; w.y = pkv[1]; w.z = pkv[2]; w.w = pkv[3]; *(u32x4*)(UV + ch * WY_TS + 16 + th * 8) = w; }
    if (th == 1) g16[ch] = __expf(cum);
    __syncthreads();
}

template <int MODE>
__device__ __forceinline__ void wy_block(f32x4 (&acc)[4][4], unsigned char* lb, int h, int lane_in, bf16* UV  , unsigned char* ws_  , float* Rh  , bf16* mixrow, const float* gng, const float* gnb) {
    int lane = lane_in; asm volatile("" : "+v"(lane));
    const int r = lane & 15, g = lane >> 4;
    const bf16* Ar = (const bf16*)(lb + WY_AROW) + h * 64; const bf16* Br = (const bf16*)(lb + WY_BROW) + h * 64; const bf16* Kr = (const bf16*)(lb + WY_KROW) + h * 64; const bf16* Pr = (const bf16*)(lb + WY_PROW) + h * 64;
    const bf16* BKT = (const bf16*)(lb + WY_BKT) + (size_t)h * 64 * WY_TS;
    float* NmT = (float*)ws_; bf16* MTz = (bf16*)(ws_ + 1024); bf16* NMT = (bf16*)(ws_ + 2304);
#define WY_FENCE() asm volatile("s_waitcnt lgkmcnt(0)" ::: "memory")
    wy_bf16x8 Bs[2][4];
#pragma unroll
    for (int kk = 0; kk < 2; ++kk)
#pragma unroll
        for (int rt = 0; rt < 4; ++rt) { u32x4 w; const f32x4 x = acc[2 * kk][rt], y = acc[2 * kk + 1][rt];
            w.x = pg8::cvt_pk_bf16(x[0], x[1]); w.y = pg8::cvt_pk_bf16(x[2], x[3]); w.z = pg8::cvt_pk_bf16(y[0], y[1]); w.w = pg8::cvt_pk_bf16(y[2], y[3]); Bs[kk][rt] = __builtin_bit_cast(wy_bf16x8, w); }
    f32x4 dN = {0.f, 0.f, 0.f, 0.f}, dM = dN, dNp = dN, dMp = dN;
#pragma unroll
    for (int kk = 0; kk < 2; ++kk) { const int o = r * WY_RS + 32 * kk + 8 * g;
        const wy_bf16x8 fb = *(const wy_bf16x8*)(Br + o), fk = *(const wy_bf16x8*)(Kr + o), fa = *(const wy_bf16x8*)(Ar + o), fp = *(const wy_bf16x8*)(Pr + o);
        dN = __builtin_amdgcn_mfma_f32_16x16x32_bf16(fb, fa, dN, 0, 0, 0); dM = __builtin_amdgcn_mfma_f32_16x16x32_bf16(fk, fa, dM, 0, 0, 0);
        if (MODE == 3) { dNp = __builtin_amdgcn_mfma_f32_16x16x32_bf16(fb, fp, dNp, 0, 0, 0); dMp = __builtin_amdgcn_mfma_f32_16x16x32_bf16(fk, fp, dMp, 0, 0, 0); } }
    { unsigned long long* z = (unsigned long long*)(MTz + (lane >> 2) * WY_TS + (lane & 3) * 4); *z = 0ull; }
#pragma unroll
    for (int i = 0; i < 4; ++i) { const int s = 4 * g + i, t = r;
        NmT[t * 16 + s] = (s < t) ? dN[i] : 0.f;
        MTz[t * WY_TS + 16 + s] = (bf16)f2bf((s < t) ? dM[i] : 0.f);
        if (MODE == 3) { NMT[t * WY_TS + s] = (bf16)f2bf((s <= t) ? -dNp[i] : 0.f); NMT[t * WY_TS + 16 + s] = (bf16)f2bf((s <= t) ? dMp[i] : 0.f); } }
    f32x4 zt[4], yt[4];
#pragma unroll
    for (int rt = 0; rt < 4; ++rt) { zt[rt] = (f32x4){0.f, 0.f, 0.f, 0.f}; yt[rt] = (f32x4){0.f, 0.f, 0.f, 0.f}; }
#pragma unroll
    for (int kk = 0; kk < 2; ++kk) { const int o = r * WY_RS + 32 * kk + 4 * g;
        const wy_u32x2 a0 = *(const wy_u32x2*)(Ar + o), a1 = *(const wy_u32x2*)(Ar + o + 16), p0 = *(const wy_u32x2*)(Pr + o), p1 = *(const wy_u32x2*)(Pr + o + 16);
        const u32x4 aw = {a0.x, a0.y, a1.x, a1.y}, pw = {p0.x, p0.y, p1.x, p1.y}; const wy_bf16x8 fa = __builtin_bit_cast(wy_bf16x8, aw), fp = __builtin_bit_cast(wy_bf16x8, pw);
#pragma unroll
        for (int rt = 0; rt < 4; ++rt) { zt[rt] = __builtin_amdgcn_mfma_f32_16x16x32_bf16(fa, Bs[kk][rt], zt[rt], 0, 0, 0); if (MODE == 3) yt[rt] = __builtin_amdgcn_mfma_f32_16x16x32_bf16(fp, Bs[kk][rt], yt[rt], 0, 0, 0); } }
    WY_FENCE();
    { const wy_bf16x8 am = *(const wy_bf16x8*)(MTz + r * WY_TS + 8 * g);
#pragma unroll
      for (int rt = 0; rt < 4; ++rt) { const wy_bf16x8 buv = *(const wy_bf16x8*)(UV + (16 * rt + r) * WY_TS + 8 * g); zt[rt] = __builtin_amdgcn_mfma_f32_16x16x32_bf16(am, buv, zt[rt], 0, 0, 0); } }
#pragma unroll
    for (int rt = 0; rt < 4; ++rt) *(f32x4*)(Rh + (16 * rt + r) * WY_RH + 4 * g) = zt[rt];
    WY_FENCE();
    { float u[16];
#pragma unroll
      for (int q = 0; q < 4; ++q) { const f32x4 x = *(const f32x4*)(Rh + lane * WY_RH + 4 * q); u[4 * q] = x.x; u[4 * q + 1] = x.y; u[4 * q + 2] = x.z; u[4 * q + 3] = x.w; }
#pragma unroll
      for (int t = 1; t < 16; ++t) { float x = u[t];
#pragma unroll
          for (int s4 = 0; s4 < (t + 3) / 4; ++s4) { const f32x4 n = *(const f32x4*)(NmT + t * 16 + 4 * s4);
#pragma unroll
              for (int q = 0; q < 4; ++q) if (4 * s4 + q < t) x -= u[4 * s4 + q] * n[q]; }
          u[t] = x; asm volatile("" ::: "memory"); }
      u32x4 o0, o1; o0.x = pg8::cvt_pk_bf16(u[0], u[1]); o0.y = pg8::cvt_pk_bf16(u[2], u[3]); o0.z = pg8::cvt_pk_bf16(u[4], u[5]); o0.w = pg8::cvt_pk_bf16(u[6], u[7]);
      o1.x = pg8::cvt_pk_bf16(u[8], u[9]); o1.y = pg8::cvt_pk_bf16(u[10], u[11]); o1.z = pg8::cvt_pk_bf16(u[12], u[13]); o1.w = pg8::cvt_pk_bf16(u[14], u[15]);
      *(u32x4*)(UV + lane * WY_TS) = o0; *(u32x4*)(UV + lane * WY_TS + 8) = o1; }
    WY_FENCE();
    wy_bf16x8 buv[4];
#pragma unroll
    for (int rt = 0; rt < 4; ++rt) buv[rt] = *(const wy_bf16x8*)(UV + (16 * rt + r) * WY_TS + 8 * g);
    if (MODE == 3) { const wy_bf16x8 an = *(const wy_bf16x8*)(NMT + r * WY_TS + 8 * g);
#pragma unroll
        for (int rt = 0; rt < 4; ++rt) yt[rt] = __builtin_amdgcn_mfma_f32_16x16x32_bf16(an, buv[rt], yt[rt], 0, 0, 0); }
    const float* g16 = (const float*)(lb + WY_G16) + h * 64;
#pragma unroll
    for (int jt = 0; jt < 4; ++jt) { const wy_bf16x8 ab = *(const wy_bf16x8*)(BKT + (16 * jt + r) * WY_TS + 8 * g); const f32x4 gm = *(const f32x4*)(g16 + 16 * jt + 4 * g);
#pragma unroll
        for (int rt = 0; rt < 4; ++rt) { f32x4 n = __builtin_amdgcn_mfma_f32_16x16x32_bf16(ab, buv[rt], acc[jt][rt], 0, 0, 0); acc[jt][rt] = n * gm; } }
    if (MODE == 3) {
        const float* Vp = (const float*)(lb + WY_VP) + h * 64; const float* Gt = (const float*)(lb + WY_G) + h * 64; const float* bsum = (const float*)(lb + WY_BSUM);
        float gg[4], gb[4];
#pragma unroll
        for (int rt = 0; rt < 4; ++rt) { gg[rt] = gng[16 * rt + r]; gb[rt] = gnb[16 * rt + r]; }
#pragma unroll
        for (int i = 0; i < 4; ++i) { const int t = 4 * g + i;
            float s1 = (yt[0][i] + yt[1][i]) + (yt[2][i] + yt[3][i]);
            s1 = row16_sum(s1);
            const float mean = s1 * (1.f / 64.f); float s2 = 0.f;
#pragma unroll
            for (int rt = 0; rt < 4; ++rt) { const float dlt = yt[rt][i] - mean; s2 += dlt * dlt; }
            s2 = row16_sum(s2);
            const float rstd = 1.f / sqrtf(s2 * (1.f / 64.f) + GN_EPS); const float bs = bsum[t * 4 + h];
#pragma unroll
            for (int rt = 0; rt < 4; ++rt) { const int row = 16 * rt + r; const float yn = (yt[rt][i] - mean) * rstd * gg[rt] + gb[rt];
                const float o = (yn + bs * Vp[t * 256 + row]) * Gt[t * 256 + row];
                mixrow[(size_t)t * DM + row] = (bf16)f2bf(o); } }
    }
#undef WY_FENCE
}

template <int EPI>
__device__ __forceinline__ void side_gemm(const bf16* A, const bf16* Bt, int K, int N, bf16* O, int ldo, float alpha, unsigned char* lds_, int bid, int G) {
    typedef short bf16x8 __attribute__((ext_vector_type(8)));
    int tid = threadIdx.x; asm volatile("" : "+v"(tid)); const int lane = tid & 63, wv_ = __builtin_amdgcn_readfirstlane(tid >> 6), r = lane & 15, g = lane >> 4;
    f32x4* red = (f32x4*)lds_;
    for (int nt = bid; nt < N / 16; nt += G) {
        f32x4 acc[8];
#pragma unroll
        for (int mt = 0; mt < 8; ++mt) acc[mt] = (f32x4){0.f, 0.f, 0.f, 0.f};
        const int kw = K / 8; const bf16* bp = Bt + (size_t)(16 * nt + r) * K + wv_ * kw + 8 * g; const bf16* ap = A + (size_t)r * K + wv_ * kw + 8 * g;
#pragma unroll 2
        for (int ks = 0; ks < kw / 32; ++ks) { const bf16x8 fb = *(const bf16x8*)(bp + 32 * ks);
#pragma unroll
            for (int mt = 0; mt < 8; ++mt) { const bf16x8 fa = *(const bf16x8*)(ap + (size_t)(16 * mt) * K + 32 * ks); acc[mt] = __builtin_amdgcn_mfma_f32_16x16x32_bf16(fa, fb, acc[mt], 0, 0, 0); } }
#pragma unroll
        for (int mt = 0; mt < 8; ++mt) red[(wv_ * 8 + mt) * 64 + lane] = acc[mt];
        __syncthreads();
        { const int mt = tid >> 6; f32x4 s = red[mt * 64 + lane];
#pragma unroll
          for (int w = 1; w < 8; ++w) s += red[(w * 8 + mt) * 64 + lane];
          const int n = 16 * nt + r;
#pragma unroll
          for (int i = 0; i < 4; ++i) { const int row = 16 * mt + 4 * g + i; bf16* op = O + (size_t)row * ldo + n; float v = s[i];
              if (EPI == 1) v = alpha * bf2f(*op) + v;
              if (EPI == 2) { v = v > 0.f ? v : 0.f; v = v * v; }
              *op = (bf16)f2bf(v); } }
        __syncthreads();
    }
}

#define XB_TMO      128
#define XB_XCNT(j)  (256  + 64 * (j))
#define XB_XSUB(j)  (1280 + 64 * (j))
#define XB_XGEN(j)  (2304 + 64 * (j))
#define XB_TOP      3328
#define XB_TOPGEN   3392
#define XCD_BAR_WORDS 3456
#define XB_SPIN_CAP (1u << 18)

__device__ __forceinline__ unsigned xb_ld(unsigned* p)              { return __hip_atomic_load(p, __ATOMIC_RELAXED, __HIP_MEMORY_SCOPE_AGENT); }
__device__ __forceinline__ unsigned xb_add(unsigned* p, unsigned v) { return __hip_atomic_fetch_add(p, v, __ATOMIC_RELAXED, __HIP_MEMORY_SCOPE_AGENT); }
__device__ __forceinline__ unsigned xb_xcc_id() { return (unsigned)__builtin_amdgcn_s_getreg((3 << 11) | 20) & 0xFu; }
#define XB_SPIN(cond, bar) do { unsigned _sp = 0; while (cond) { __builtin_amdgcn_s_sleep(1); \
    if ((++_sp & 255u) == 0u) { if (xb_ld(&(bar)[XB_TMO])) break; if (_sp > XB_SPIN_CAP) { atomicAdd(&(bar)[XB_TMO], 1u); break; } } } } while (0)

struct XcdBarrier {
    unsigned* bar; unsigned x;
    volatile PG8_LAS unsigned* st;
};

__device__ __forceinline__ XcdBarrier xcd_barrier_post(unsigned* bar, volatile PG8_LAS unsigned* st) {
    XcdBarrier b; b.bar = bar; b.x = xb_xcc_id(); b.st = st;
    if (threadIdx.x == 0) (void)xb_add(&bar[XB_XCNT(b.x)], 1u);
    return b;
}
__device__ __forceinline__ void xcd_barrier_complete(unsigned* bar, unsigned x, unsigned& nloc, unsigned& nx) {
    const unsigned G = gridDim.x * gridDim.y * gridDim.z;
    unsigned sum, cnt, mine, sp = 0u;
    for (;;) {
        sum = 0u; cnt = 0u; mine = 0u;
#pragma unroll
        for (unsigned j = 0; j < 16; ++j) { const unsigned c = xb_ld(&bar[XB_XCNT(j)]); sum += c; cnt += (c > 0u) ? 1u : 0u; mine = (j == x) ? c : mine; }
        if (sum == G) break;
        __builtin_amdgcn_s_sleep(1);
        if ((++sp & 255u) == 0u) { if (xb_ld(&bar[XB_TMO])) break; if (sp > XB_SPIN_CAP) { atomicAdd(&bar[XB_TMO], 1u); break; } }
    }
    nloc = mine > 0u ? mine : 1u; nx = cnt > 0u ? cnt : 1u;
}

__device__ __forceinline__ void xcd_barrier(const XcdBarrier& b) {
    asm volatile("s_waitcnt vmcnt(0)" ::: "memory");
    __syncthreads();
    if (threadIdx.x == 0) {
        unsigned* bar = b.bar;
        __builtin_amdgcn_s_waitcnt(0);
        unsigned nloc = b.st[0], nx = b.st[1];
        if (nloc == 0u) { xcd_barrier_complete(bar, b.x, nloc, nx); b.st[0] = nloc; b.st[1] = nx; }
        const unsigned old = xb_add(&bar[XB_XSUB(b.x)], 1u);
        const unsigned gen = old / nloc;
        if (old + 1u == (gen + 1u) * nloc) {
            __builtin_amdgcn_fence(__ATOMIC_RELEASE, "agent");
            asm volatile("s_waitcnt vmcnt(0)" ::: "memory");
            const unsigned og = xb_add(&bar[XB_TOP], 1u);
            const unsigned tg = og / nx;
            if (og + 1u == (tg + 1u) * nx) xb_add(&bar[XB_TOPGEN], 1u);
            else XB_SPIN(xb_ld(&bar[XB_TOPGEN]) == tg, bar);
            __builtin_amdgcn_fence(__ATOMIC_ACQUIRE, "agent");
            xb_add(&bar[XB_XGEN(b.x)], 1u);
            asm volatile("s_waitcnt vmcnt(0)" ::: "memory");
        } else {
            XB_SPIN(xb_ld(&bar[XB_XGEN(b.x)]) == gen, bar);
            __builtin_amdgcn_fence(__ATOMIC_ACQUIRE, "agent");
            asm volatile("s_waitcnt vmcnt(0)" ::: "memory");
        }
    }
    __syncthreads();
}

__global__ void __launch_bounds__(NTHR, 2) hybrid_fwd(Args a0) {
    extern __shared__ __attribute__((aligned(16))) unsigned char lds[];
    cg::grid_group grid = cg::this_grid();
    const int G = gridDim.x, bid = blockIdx.x, NGW = G * 8;
    unsigned char* const ws_g = a0.ws; unsigned char* ws = ws_g;
#define hb ((bf16*)(ws + WS_HB))
#define pbuf ((bf16*)(ws + WS_U + U_P))
#define mix ((bf16*)(ws + WS_U + U_MIX))
#define acg ((bf16*)(ws + WS_U + U_ACG))
#define ffh ((bf16*)(ws + WS_U))
#define lruA ((float*)(ws + WS_LRUA))
#define lruH ((float*)(ws + WS_LRUH))
#define lruS ((float*)(ws + WS_LRUS))
#define mlN ((float*)(ws + WS_MLN))
#define mlM ((float*)(ws + WS_MLM))
#define mlB ((float*)(ws + WS_MLB))
#define mlP ((float*)(ws + WS_MLP))
    unsigned char* const dsc_g = (unsigned char*)a0.out; unsigned char* dsc = dsc_g; (void)dsc;
#define vfirst ((bf16*)(dsc + DO_VF))
#define rwP ((float*)(dsc + DO_RWP))
#define rwS ((float*)(dsc + DO_RWS))
#define mlC ((float*)(dsc + DO_MLC))
    float* L = (float*)lds;
    volatile PG8_LAS unsigned* xst = (volatile PG8_LAS unsigned*)((PG8_LAS unsigned char*)lds + LDS_BYTES - 64);
    if (threadIdx.x == 0) { xst[0] = 0u; xst[1] = 0u; }
    __syncthreads();
    (void)xcd_barrier_post((unsigned*)(a0.ws + WS_BAR), xst);
#define GBAR() do { XcdBarrier b_; b_.bar = (unsigned*)(a0.ws + WS_BAR); b_.x = xb_xcc_id(); b_.st = (volatile PG8_LAS unsigned*)((PG8_LAS unsigned char*)lds + LDS_BYTES - 64); xcd_barrier(b_); } while (0)
    Args a;
    { const float* par = (const float*)(a0.ws + WS_PAR);
      constexpr int PSZ[38] = {0, 0, 0, 0, 0, 0, 65536, 1024, 3584, 1024, 32768, 1024, 32768, 65536, 1024, 1024, 1024, 1024, 1024, 768, 24576, 24576, 4096, 1024, 65536, 1024, 65536, 1024, 1024, 32, 1024, 1024, 4096, 4096, 4096, 4096, 0, 0}; constexpr int POFF[38] = {0, 0, 0, 0, 0, 0, 0, 65536, 66560, 70144, 71168, 103936, 104960, 137728, 203264, 204288, 205312, 206336, 207360, 208384, 209152, 233728, 258304, 262400, 263424, 328960, 329984, 395520, 396544, 397568, 397600, 398624, 399648, 403744, 407840, 411936, 0, 0};
#pragma unroll
      for (int i = 0; i < 38; ++i) a.in[i] = (PSZ[i] > 0) ? par + POFF[i] : a0.in[i];
      a.out = a0.out; a.ws = a0.ws;
      { bf16* wt3 = (bf16*)(a0.ws + WS_WT3);
        for (int e = blockIdx.x * NTHR + threadIdx.x; e < DEPTH * 3 * 4 * 4096; e += gridDim.x * NTHR) { const int cc = e & 63, n = (e >> 6) & 63, g = (e >> 12) & 3, lm = e >> 14, m = lm % 3, l = lm / 3;
            const float* src = (m == 0) ? a0.in[6] : (m == 1) ? a0.in[24] : a0.in[26];
            wt3[e] = (bf16)f2bf(src[(size_t)((l * 4 + g) * 64 + cc) * 64 + n]); } }
      { bf16* wt4 = (bf16*)(a0.ws + WS_WT4);
        for (int e = blockIdx.x * NTHR + threadIdx.x; e < DEPTH * 49152; e += gridDim.x * NTHR) { const int l = e / 49152, o = e % 49152; float v = 0.f;
            if (o < 8192) { const int ch = o >> 5, j = o & 31; v = a0.in[10][((size_t)l * 32 + j) * 256 + ch]; }
            else if (o < 16384) { const int q = o - 8192, ch = q >> 5, j = q & 31; v = a0.in[12][((size_t)l * 32 + j) * 256 + ch]; }
            else if (o < 24576) { const int q = o - 16384, ch = q >> 5, j = q & 31; if (l > 0) v = a0.in[21][((size_t)(l - 1) * 32 + j) * 256 + ch]; }
            else if (o < 40960) { const int q = o - 24576, ch = q >> 6, j = q & 63; v = a0.in[13][((size_t)l * 64 + j) * 256 + ch]; }
            else { const int q = o - 40960, j = q >> 8, cc = q & 255; if (l > 0) v = a0.in[20][((size_t)(l - 1) * 256 + cc) * 32 + j]; }
            wt4[e] = (bf16)f2bf(v); } }
      float* pw_ = (float*)(a0.ws + WS_PAR);
#pragma unroll 1
      for (int i = 0; i < 38; ++i) { const int n = PSZ[i]; if (n > 0) { const float* src = a0.in[i]; for (int e = blockIdx.x * NTHR + threadIdx.x; e < n; e += gridDim.x * NTHR) pw_[POFF[i] + e] = src[e]; } } }

    {
        int tid = threadIdx.x; asm volatile("" : "+v"(tid)); unsigned char* ws = ws_g; asm volatile("" : "+s"(ws)); unsigned char* dsc = dsc_g; asm volatile("" : "+s"(dsc)); (void)ws; (void)dsc; const int lane = tid & 63, wave = __builtin_amdgcn_readfirstlane(tid >> 6); const int gw = bid * 8 + wave; (void)lane; (void)gw;
        float* scr = L + wave * (64 * 33);
        constexpr int I_IN = (DM / 64) * (DINP / 32), I_OUT = (DM / 64) * (DM / 32), I_1 = (DM / 64) * (FF / 32), I_2 = (FF / 64) * (DM / 32), I_L = I_IN + I_OUT + I_1 + I_2;
        for (int it = gw; it < DEPTH * I_L; it += NGW) {
            const int l = it / I_L; int r = it % I_L; unsigned char* wl = ws + WS_W + (size_t)l * LW_SZ;
            if (r < I_IN) { transpose_item(a.in[4] + (size_t)l * DM * DIN, DM, DIN, DINP, (bf16*)(wl + LW_IN), scr, r, lane); continue; } r -= I_IN;
            if (r < I_OUT) { transpose_item(a.in[5] + (size_t)l * DM * DM, DM, DM, DM, (bf16*)(wl + LW_OUT), scr, r, lane); continue; } r -= I_OUT;
            if (r < I_1) { transpose_item(a.in[36] + (size_t)l * DM * FF, DM, FF, FF, (bf16*)(wl + LW_1), scr, r, lane); continue; } r -= I_1;
            transpose_item(a.in[37] + (size_t)l * FF * DM, FF, DM, DM, (bf16*)(wl + LW_2), scr, r, lane);
        }
        for (int m = gw; m < MP; m += NGW) {
            bf16* orow = hb + (size_t)m * DM; const int tp = (m - MMAIN) & 63;
            if (m >= MMAIN + 128 || (m >= MMAIN && tp < PADT)) { u32x4 z = {0u, 0u, 0u, 0u}; ((u32x4*)orow)[lane] = z; ((u32x4*)orow)[lane + 64] = z; }
            else { const float* src = (m >= MMAIN) ? a.in[1] + (size_t)(tp - PADT) * DM : a.in[0] + (size_t)m * DM;
                ln_row_f32_to_bf16(src, a.in[2], a.in[3], orow, lane); }
        }
    }
    grid.sync();

    for (int l = 0; l < DEPTH; ++l) {
        unsigned char* wl = ws + WS_W + (size_t)l * LW_SZ;
        { pg8::Gemm g{hb, (const bf16*)(wl + LW_IN), MMAIN, DINP, DM}; pg8::StaticOrder S; S.init(MMAIN, DINP, G, bid);
          pg8::EpiStore<0> E{pbuf, DINP};
          pg8::gemm_phase<pg8::EpiStore<0>, pg8::StaticOrder, true, true>((PG8_LAS unsigned char*)lds, g, S, E); }
        if (G == 256) { if (bid >= 128) side_gemm<0>(hb + (size_t)MMAIN * DM, (const bf16*)(wl + LW_IN), DM, DINP, pbuf + (size_t)MMAIN * DINP, DINP, 0.f, lds, bid - 128, 128); }
        else side_gemm<0>(hb + (size_t)MMAIN * DM, (const bf16*)(wl + LW_IN), DM, DINP, pbuf + (size_t)MMAIN * DINP, DINP, 0.f, lds, bid, G);
        GBAR();

#pragma unroll 1
        for (int it_ = 0; it_ < 3; ++it_) {
            const int qs_ = bid - (G - 16);
            const int ui = (it_ < 2) ? bid + G * it_ : (((unsigned)qs_ < 8u) ? 512 + (qs_ >> 2) : -1);
            if (ui < 0 || (it_ < 2 && ui >= 512)) continue;
            const int segsel = (it_ < 2) ? 15 : (1 << (qs_ & 3));
            const int b = (ui < 512) ? (ui & 1) : (ui - 512), c = (ui < 512) ? 1 + (ui >> 1) : 0;
            const int row0 = (c == 0) ? MMAIN + 64 * b : b * SEQ + 64 * (c - 1), tv0 = (c == 0) ? PADT : 0, bci = b * NCH + c;
            const int hrb = (c == 1) ? MMAIN + 64 * b + 64 : row0;
            int tid = threadIdx.x; asm volatile("" : "+v"(tid)); unsigned char* ws = ws_g; asm volatile("" : "+s"(ws)); unsigned char* dsc = dsc_g; asm volatile("" : "+s"(dsc)); (void)ws; (void)dsc; const int lane = tid & 63, wave = __builtin_amdgcn_readfirstlane(tid >> 6); const int gw = bid * 8 + wave; (void)lane; (void)gw;
#ifndef NO_SEG_POOL
            if (segsel & 2) {
            int tid = threadIdx.x; asm volatile("" : "+v"(tid)); unsigned char* ws = ws_g; asm volatile("" : "+s"(ws)); unsigned char* dsc = dsc_g; asm volatile("" : "+s"(dsc)); (void)ws; (void)dsc; const int lane = tid & 63; (void)lane;
                typedef short bf16x8 __attribute__((ext_vector_type(8)));
                typedef unsigned u32x2 __attribute__((ext_vector_type(2)));
                bf16* ub = (bf16*)L;
                bf16* dB = (bf16*)(L + 10240);
                { u32x4 v[5];
#pragma unroll
                  for (int i = 0; i < 5; ++i) { const int idx = tid + NTHR * i, rr = idx >> 5, c8 = idx & 31, tl = rr - 16; const bool ok = (64 * c + tl >= PADT);
                      v[i] = (u32x4){0u, 0u, 0u, 0u}; if (ok) v[i] = *(const u32x4*)(pbuf + (size_t)(tl < 0 ? hrb + tl : row0 + tl) * DINP + PC_POOL + c8 * 8); }
#pragma unroll
                  for (int i = 0; i < 5; ++i) { const int idx = tid + NTHR * i; *(u32x4*)(ub + idx * 8) = v[i]; } }
                __syncthreads();
#pragma unroll 1
                for (int i = 0; i < 4; ++i) { const int idx = tid + NTHR * i, t = idx >> 5, c8 = idx & 31, g = c8 >> 3, w = 2 << g;
                    const int treal = 64 * c + t - PADT; const int cnt = (treal + 1 < w) ? treal + 1 : w;
                    float s[8];
#pragma unroll
                    for (int q = 0; q < 8; ++q) s[q] = 0.f;
                    for (int j = 0; j < w; ++j) { const u32x4 q4 = *(const u32x4*)(ub + (t + 16 - j) * 256 + c8 * 8);
                        s[0] += pg8::bflo(q4.x); s[1] += pg8::bfhi(q4.x); s[2] += pg8::bflo(q4.y); s[3] += pg8::bfhi(q4.y); s[4] += pg8::bflo(q4.z); s[5] += pg8::bfhi(q4.z); s[6] += pg8::bflo(q4.w); s[7] += pg8::bfhi(q4.w); }
                    const u32x4 c4 = *(const u32x4*)(ub + (t + 16) * 256 + c8 * 8);
                    const float cur[8] = {pg8::bflo(c4.x), pg8::bfhi(c4.x), pg8::bflo(c4.y), pg8::bfhi(c4.y), pg8::bflo(c4.z), pg8::bfhi(c4.z), pg8::bflo(c4.w), pg8::bfhi(c4.w)};
                    const float ic = (treal >= 0) ? 1.f / (float)cnt : 0.f;
                    float d[8];
#pragma unroll
                    for (int q = 0; q < 8; ++q) d[q] = (treal >= 0) ? s[q] * ic - cur[q] : 0.f;
                    u32x4 o; o.x = pk2(d[0], d[1]); o.y = pk2(d[2], d[3]); o.z = pk2(d[4], d[5]); o.w = pk2(d[6], d[7]);
                    *(u32x4*)(dB + t * 264 + c8 * 8) = o; }
                __syncthreads();
                {
                    const int wv_ = tid >> 6, g = wv_ & 3, th = wv_ >> 2, r = lane & 15, gq = lane >> 4;
                    const bf16* wt = (const bf16*)(ws + WS_WT3) + (size_t)((l * 3 + 0) * 4 + g) * 4096;
                    bf16x8 af[4][2];
#pragma unroll
                    for (int nt = 0; nt < 4; ++nt)
#pragma unroll
                        for (int kk = 0; kk < 2; ++kk) af[nt][kk] = *(const bf16x8*)(wt + (16 * nt + r) * 64 + 32 * kk + 8 * gq);
                    f32x4 acc[4][2];
#pragma unroll
                    for (int nt = 0; nt < 4; ++nt) { acc[nt][0] = (f32x4){0.f, 0.f, 0.f, 0.f}; acc[nt][1] = (f32x4){0.f, 0.f, 0.f, 0.f}; }
#pragma unroll
                    for (int tt = 0; tt < 2; ++tt)
#pragma unroll
                        for (int kk = 0; kk < 2; ++kk) { const bf16x8 bfr = *(const bf16x8*)(dB + (32 * th + 16 * tt + r) * 264 + g * 64 + 32 * kk + 8 * gq);
#pragma unroll
                            for (int nt = 0; nt < 4; ++nt) acc[nt][tt] = __builtin_amdgcn_mfma_f32_16x16x32_bf16(af[nt][kk], bfr, acc[nt][tt], 0, 0, 0); }
#pragma unroll
                    for (int nt = 0; nt < 4; ++nt) { const int col = g * 64 + 16 * nt + 4 * gq; const f32x4 sc = *(const f32x4*)(a.in[7] + l * 256 + col);
#pragma unroll
                        for (int tt = 0; tt < 2; ++tt) { const int t = 32 * th + 16 * tt + r; const bool val = t >= tv0;
                            u32x2 o; o.x = pk2(val ? acc[nt][tt][0] * sc[0] : 0.f, val ? acc[nt][tt][1] * sc[1] : 0.f); o.y = pk2(val ? acc[nt][tt][2] * sc[2] : 0.f, val ? acc[nt][tt][3] * sc[3] : 0.f);
                            *(u32x2*)(mix + (size_t)(row0 + t) * DM + col) = o; } }
                }
                __syncthreads();
            }
#endif
#ifndef NO_SEG_LRU1
            if (segsel & 4) {
            int tid = threadIdx.x; asm volatile("" : "+v"(tid)); unsigned char* ws = ws_g; asm volatile("" : "+s"(ws)); unsigned char* dsc = dsc_g; asm volatile("" : "+s"(dsc)); (void)ws; (void)dsc; const int lane = tid & 63; (void)lane;
                typedef short bf16x8 __attribute__((ext_vector_type(8)));
                typedef unsigned u32x2 __attribute__((ext_vector_type(2)));
                bf16* xb = (bf16*)L;
                bf16* gt = xb + 68 * 256;
                bf16* xcB = gt + 64 * 256;
                bf16* uB = xcB + 64 * 264;
                float* ex = (float*)(uB + 64 * 264);
                bf16* laB = xb;
                { u32x4 v[5], gv[4];
#pragma unroll
                  for (int i = 0; i < 5; ++i) { const int idx = tid + NTHR * i, rr = idx >> 5, c8 = idx & 31, tl = rr - 4; const bool ok = (idx < 68 * 32) && (64 * c + tl >= PADT);
                      v[i] = (u32x4){0u, 0u, 0u, 0u}; if (ok) v[i] = *(const u32x4*)(pbuf + (size_t)(tl < 0 ? hrb + tl : row0 + tl) * DINP + PC_LX + c8 * 8); }
#pragma unroll
                  for (int i = 0; i < 4; ++i) { const int idx = tid + NTHR * i, rr = idx >> 5, c8 = idx & 31; gv[i] = *(const u32x4*)(pbuf + (size_t)(row0 + rr) * DINP + PC_LG + c8 * 8); }
#pragma unroll
                  for (int i = 0; i < 5; ++i) { const int idx = tid + NTHR * i; if (idx < 68 * 32) *(u32x4*)(xb + idx * 8) = v[i]; }
#pragma unroll
                  for (int i = 0; i < 4; ++i) { const int idx = tid + NTHR * i; *(u32x4*)(gt + idx * 8) = gv[i]; } }
                __syncthreads();
                { const float* cw = a.in[22] + (size_t)l * 4 * 256; const float* cb = a.in[23] + l * 256;
#pragma unroll 1
                  for (int i = 0; i < 4; ++i) { const int idx = tid + NTHR * i, t = idx >> 5, c8 = idx & 31;
                    float o[8];
                    { const f32x4 b0 = *(const f32x4*)(cb + c8 * 8), b1 = *(const f32x4*)(cb + c8 * 8 + 4);
#pragma unroll
                      for (int q = 0; q < 4; ++q) { o[q] = b0[q]; o[4 + q] = b1[q]; } }
#pragma unroll
                    for (int j = 0; j < 4; ++j) { const u32x4 q4 = *(const u32x4*)(xb + (t + 1 + j) * 256 + c8 * 8);
                        const f32x4 w0 = *(const f32x4*)(cw + j * 256 + c8 * 8), w1 = *(const f32x4*)(cw + j * 256 + c8 * 8 + 4);
                        o[0] += w0[0] * pg8::bflo(q4.x); o[1] += w0[1] * pg8::bfhi(q4.x); o[2] += w0[2] * pg8::bflo(q4.y); o[3] += w0[3] * pg8::bfhi(q4.y);
                        o[4] += w1[0] * pg8::bflo(q4.z); o[5] += w1[1] * pg8::bfhi(q4.z); o[6] += w1[2] * pg8::bflo(q4.w); o[7] += w1[3] * pg8::bfhi(q4.w); }
                    const bool val = t >= tv0;
                    u32x4 ow; ow.x = pk2(val ? o[0] : 0.f, val ? o[1] : 0.f); ow.y = pk2(val ? o[2] : 0.f, val ? o[3] : 0.f); ow.z = pk2(val ? o[4] : 0.f, val ? o[5] : 0.f); ow.w = pk2(val ? o[6] : 0.f, val ? o[7] : 0.f);
                    *(u32x4*)(xcB + t * 264 + c8 * 8) = ow; } }
                __syncthreads();
                {
                    const int wv_ = tid >> 6, g = wv_ & 3, th = wv_ >> 2, r = lane & 15, gq = lane >> 4;
                    const bf16* wta = (const bf16*)(ws + WS_WT3) + (size_t)((l * 3 + 1) * 4 + g) * 4096; const bf16* wtx = (const bf16*)(ws + WS_WT3) + (size_t)((l * 3 + 2) * 4 + g) * 4096;
                    f32x4 accR[4][2], accI[4][2];
#pragma unroll
                    for (int nt = 0; nt < 4; ++nt) { accR[nt][0] = (f32x4){0.f, 0.f, 0.f, 0.f}; accR[nt][1] = accR[nt][0]; accI[nt][0] = accR[nt][0]; accI[nt][1] = accR[nt][0]; }
#pragma unroll
                    for (int kk = 0; kk < 2; ++kk) { bf16x8 b0 = *(const bf16x8*)(xcB + (32 * th + r) * 264 + g * 64 + 32 * kk + 8 * gq), b1 = *(const bf16x8*)(xcB + (32 * th + 16 + r) * 264 + g * 64 + 32 * kk + 8 * gq);
#pragma unroll
                        for (int nt = 0; nt < 4; ++nt) { const bf16x8 fa = *(const bf16x8*)(wta + (16 * nt + r) * 64 + 32 * kk + 8 * gq), fx = *(const bf16x8*)(wtx + (16 * nt + r) * 64 + 32 * kk + 8 * gq);
                            accR[nt][0] = __builtin_amdgcn_mfma_f32_16x16x32_bf16(fa, b0, accR[nt][0], 0, 0, 0); accR[nt][1] = __builtin_amdgcn_mfma_f32_16x16x32_bf16(fa, b1, accR[nt][1], 0, 0, 0);
                            accI[nt][0] = __builtin_amdgcn_mfma_f32_16x16x32_bf16(fx, b0, accI[nt][0], 0, 0, 0); accI[nt][1] = __builtin_amdgcn_mfma_f32_16x16x32_bf16(fx, b1, accI[nt][1], 0, 0, 0); } }
#pragma unroll
                    for (int nt = 0; nt < 4; ++nt) { const int col = g * 64 + 16 * nt + 4 * gq;
                        const f32x4 gab = *(const f32x4*)(a.in[25] + l * 256 + col), gxb = *(const f32x4*)(a.in[27] + l * 256 + col), lam = *(const f32x4*)(a.in[28] + l * 256 + col);
#pragma unroll
                        for (int tt = 0; tt < 2; ++tt) { const int t = 32 * th + 16 * tt + r; const u32x2 xw = *(const u32x2*)(xcB + t * 264 + col);
                            const float xv[4] = {pg8::bflo(xw.x), pg8::bfhi(xw.x), pg8::bflo(xw.y), pg8::bfhi(xw.y)}; float la[4], uu[4];
#pragma unroll
                            for (int i = 0; i < 4; ++i) { const float rr = sigmoidf_(accR[nt][tt][i] + gab[i]), ig = sigmoidf_(accI[nt][tt][i] + gxb[i]); la[i] = -8.f * rr * softplusf_(-lam[i]); uu[i] = sqrtf(1.f - __expf(2.f * la[i])) * (ig * xv[i]); }
                            u32x2 lo_, uo_; lo_.x = pk2(la[0], la[1]); lo_.y = pk2(la[2], la[3]); uo_.x = pk2(uu[0], uu[1]); uo_.y = pk2(uu[2], uu[3]);
                            *(u32x2*)(laB + t * 264 + col) = lo_; *(u32x2*)(uB + t * 264 + col) = uo_; } }
                }
                __syncthreads();
                const int col = tid & 255, th = tid >> 8;
                float hh = 0.f, AA = 1.f;
#pragma unroll
                for (int half = 0; half < 2; ++half) {
                    if (th == half) {
                        if (half == 1) { hh = ex[col]; AA = ex[256 + col]; }
#pragma unroll 4
                        for (int i = 0; i < 32; ++i) { const int t = th * 32 + i; const size_t row = (size_t)(row0 + t);
                            float o1 = 0.f, o2 = 0.f;
                            if (t >= tv0) { const float av = __expf(bf2f(laB[t * 264 + col])); hh = av * hh + bf2f(uB[t * 264 + col]); AA *= av;
                                const float gl = gelu_tanh(bf2f(gt[t * 256 + col])); o1 = hh * gl; o2 = AA * gl; }
                            mix[row * DM + 512 + col] = (bf16)f2bf(o1); acg[row * 256 + col] = (bf16)f2bf(o2); }
                        if (half == 0) { ex[col] = hh; ex[256 + col] = AA; } else { lruA[bci * 256 + col] = AA; lruH[bci * 256 + col] = hh; }
                    }
                    __syncthreads();
                }
            }
#endif
#ifndef NO_SEG_ML1
            if (segsel & 8) {
            int tid = threadIdx.x; asm volatile("" : "+v"(tid)); unsigned char* ws = ws_g; asm volatile("" : "+s"(ws)); unsigned char* dsc = dsc_g; asm volatile("" : "+s"(dsc)); (void)ws; (void)dsc; const int lane = tid & 63; (void)lane;
                typedef short bf16x8 __attribute__((ext_vector_type(8)));
                float* li = L, *bc = L + 256, *wl = L + 512;
                bf16* VwT = (bf16*)(L + 2048);
                bf16* KT = VwT + 256 * 72;
                ml_gates<1>(pbuf, a.in[29], l, row0, tv0, bci, li, bc, wl, nullptr, nullptr, mlM, mlB, nullptr, tid);
                { u32x4 kv[4], vv[4];
#pragma unroll
                  for (int i = 0; i < 4; ++i) { const int idx = tid + NTHR * i, s = idx & 63, c8 = idx >> 6; const bf16* src = pbuf + (size_t)(row0 + s) * DINP + c8 * 8;
                      kv[i] = *(const u32x4*)(src + PC_MK); vv[i] = *(const u32x4*)(src + PC_MV); }
#pragma unroll
                  for (int i = 0; i < 4; ++i) { const int idx = tid + NTHR * i, s = idx & 63, c8 = idx >> 6; const float w = wl[s * 4 + (c8 >> 3)];
                      bf16* dk = KT + (size_t)(c8 * 8) * 72 + s; bf16* dv = VwT + (size_t)(c8 * 8) * 72 + s;
                      dk[0 * 72] = (bf16)(kv[i].x & 0xffffu); dk[1 * 72] = (bf16)(kv[i].x >> 16); dk[2 * 72] = (bf16)(kv[i].y & 0xffffu); dk[3 * 72] = (bf16)(kv[i].y >> 16);
                      dk[4 * 72] = (bf16)(kv[i].z & 0xffffu); dk[5 * 72] = (bf16)(kv[i].z >> 16); dk[6 * 72] = (bf16)(kv[i].w & 0xffffu); dk[7 * 72] = (bf16)(kv[i].w >> 16);
                      dv[0 * 72] = (bf16)f2bf(pg8::bflo(vv[i].x) * w); dv[1 * 72] = (bf16)f2bf(pg8::bfhi(vv[i].x) * w); dv[2 * 72] = (bf16)f2bf(pg8::bflo(vv[i].y) * w); dv[3 * 72] = (bf16)f2bf(pg8::bfhi(vv[i].y) * w);
                      dv[4 * 72] = (bf16)f2bf(pg8::bflo(vv[i].z) * w); dv[5 * 72] = (bf16)f2bf(pg8::bfhi(vv[i].z) * w); dv[6 * 72] = (bf16)f2bf(pg8::bflo(vv[i].w) * w); dv[7 * 72] = (bf16)f2bf(pg8::bfhi(vv[i].w) * w); } }
                __syncthreads();
                {
                    const int wv_ = tid >> 6, h = wv_ >> 1, vh = wv_ & 1, r = lane & 15, gq = lane >> 4;
                    f32x4 acc[2][4];
#pragma unroll
                    for (int vt = 0; vt < 2; ++vt)
#pragma unroll
                        for (int kt = 0; kt < 4; ++kt) acc[vt][kt] = (f32x4){0.f, 0.f, 0.f, 0.f};
#pragma unroll
                    for (int kk = 0; kk < 2; ++kk) { bf16x8 af[2];
#pragma unroll
                        for (int vt = 0; vt < 2; ++vt) af[vt] = *(const bf16x8*)(VwT + (size_t)(h * 64 + 32 * vh + 16 * vt + r) * 72 + 32 * kk + 8 * gq);
#pragma unroll
                        for (int kt = 0; kt < 4; ++kt) { const bf16x8 bfr = *(const bf16x8*)(KT + (size_t)(h * 64 + 16 * kt + r) * 72 + 32 * kk + 8 * gq);
#pragma unroll
                            for (int vt = 0; vt < 2; ++vt) acc[vt][kt] = __builtin_amdgcn_mfma_f32_16x16x32_bf16(af[vt], bfr, acc[vt][kt], 0, 0, 0); } }
                    float* cdst = mlC + (size_t)(bci * 4 + h) * 4096;
#pragma unroll
                    for (int vt = 0; vt < 2; ++vt)
#pragma unroll
                        for (int kt = 0; kt < 4; ++kt)
#pragma unroll
                            for (int i = 0; i < 4; ++i) cdst[(size_t)(32 * vh + 16 * vt + 4 * gq + i) * 64 + 16 * kt + r] = acc[vt][kt][i];
                    if (tid < 256) { const int hh_ = tid >> 6, k = tid & 63; float nacc = 0.f; const bf16* kr = KT + (size_t)(hh_ * 64 + k) * 72;
#pragma unroll 8
                        for (int s = 0; s < 64; ++s) nacc += wl[s * 4 + hh_] * bf2f(kr[s]);
                        mlN[(size_t)(bci * 4 + hh_) * 64 + k] = nacc; }
                }
                __syncthreads();
            }
#endif
#ifndef NO_SEG_RW1
            if (segsel & 1) {
            int tid = threadIdx.x; asm volatile("" : "+v"(tid)); unsigned char* ws = ws_g; asm volatile("" : "+s"(ws)); unsigned char* dsc = dsc_g; asm volatile("" : "+s"(dsc)); (void)ws; (void)dsc; const int lane = tid & 63; (void)lane;
                const int wv_ = __builtin_amdgcn_readfirstlane(tid >> 6);
                int ui_l = __builtin_amdgcn_readfirstlane(ui); asm volatile("" : "+s"(ui_l)); bf16* LO = (bf16*)(ws + WS_LORA) + (size_t)ui_l * 64 * 256 * 4;
                rw_lora<3>(a, pbuf, LO, L, l, c, row0, hrb, tid);
                { unsigned z0; asm volatile("v_mov_b32 %0, 0" : "=v"(z0)); const u32x4 zz = {z0, z0, z0, z0};
                  for (int i = tid; i < WY_UVB / 16; i += NTHR) { ((u32x4*)(lds + WY_UV))[i] = zz; ((u32x4*)(lds + WY_VP))[i] = zz; } }
                const int h = wv_ & 3, r = lane & 15, g = lane >> 4; const bool pm = wv_ >= 4;
                f32x4 acc[4][4];
                { float z0; asm volatile("v_mov_b32 %0, 0" : "=v"(z0));
#pragma unroll
                  for (int jt = 0; jt < 4; ++jt)
#pragma unroll
                      for (int rt = 0; rt < 4; ++rt) { f32x4 x = {z0, z0, z0, z0};
                          if (pm && jt == rt) {
#pragma unroll
                              for (int i = 0; i < 4; ++i) x[i] = (4 * g + i == r) ? 1.f : 0.f; }
                          acc[jt][rt] = x; } }
                __syncthreads();
                for (int blk = 0; blk < 4; ++blk) {
                    const int ts = blk * 16;
                    if (ts + 16 <= tv0) continue;
                    wy_prep<1>(a, pbuf, vfirst, LO, lds, l, c, row0, hrb, ts, tid);
                    if (!pm) wy_block<1>(acc, lds, h, lane, (bf16*)(lds + WY_UV) + (size_t)h * 64 * WY_TS, lds + WY_SCR + h * WY_WSCR, (float*)(lds + WY_SCR + h * WY_WSCR + 3584), nullptr, nullptr, nullptr);
                    __syncthreads();
                    if (pm) wy_block<1>(acc, lds, h, lane, (bf16*)(lds + WY_VP) + (size_t)h * 64 * WY_TS, lds + WY_SCR + h * WY_WSCR, (float*)(lds + WY_SCR + h * WY_WSCR + 3584), nullptr, nullptr, nullptr);
                    __syncthreads();
                }
                if (pm) {
                    bf16* dst = (bf16*)(rwP + (size_t)(bci * 4 + h) * 4096);
#pragma unroll
                    for (int jt = 0; jt < 4; ++jt)
#pragma unroll
                        for (int rt = 0; rt < 4; ++rt)
#pragma unroll
                            for (int i = 0; i < 4; ++i) { const int kk = rt >> 1, gp = (r >> 2) & 3, e = ((rt & 1) << 2) | (r & 3), rl = 4 * g + i;
                                dst[((jt * 2 + kk) * 64 + gp * 16 + rl) * 8 + e] = (bf16)f2bf(acc[jt][rt][i]); }
                } else {
                    float* dst = rwS + (size_t)(bci * 4 + h) * 4096;
#pragma unroll
                    for (int jt = 0; jt < 4; ++jt)
#pragma unroll
                        for (int rt = 0; rt < 4; ++rt) *(f32x4*)(dst + ((rt * 4 + jt) * 64 + g * 16 + r) * 4) = acc[jt][rt];
                }
            }
#endif
        }
        GBAR();

#ifndef NO_PC
        {
        int tid = threadIdx.x; asm volatile("" : "+v"(tid)); unsigned char* ws = ws_g; asm volatile("" : "+s"(ws)); unsigned char* dsc = dsc_g; asm volatile("" : "+s"(dsc)); (void)ws; (void)dsc; const int lane = tid & 63, wave = __builtin_amdgcn_readfirstlane(tid >> 6); const int gw = bid * 8 + wave; (void)lane; (void)gw;
        if (bid < 64) {
            const int bh = bid >> 3, b = bh >> 2, h = bh & 3, e = (bid & 7) * 512 + tid;
            float cst = 0.f, nst = 0.f, m = 0.f; const bool don = ((bid & 7) == 0) && tid < 64;
            for (int c0 = 0; c0 < NCH; c0 += 8) {
                float cl[8], nl[8], ml_[8], bl_[8];
#pragma unroll
                for (int i = 0; i < 8; ++i) { const int c = c0 + i; if (c < NCH) { const int bci = b * NCH + c; cl[i] = mlC[(size_t)(bci * 4 + h) * 4096 + e]; nl[i] = don ? mlN[(size_t)(bci * 4 + h) * 64 + tid] : 0.f; ml_[i] = mlM[bci * 4 + h]; bl_[i] = mlB[bci * 4 + h]; } else { cl[i] = 0.f; nl[i] = 0.f; ml_[i] = 0.f; bl_[i] = 0.f; } }
#pragma unroll
                for (int i = 0; i < 8; ++i) { const int c = c0 + i; if (c < NCH) { const int bci = b * NCH + c;
                        mlC[(size_t)(bci * 4 + h) * 4096 + e] = cst; if (don) mlN[(size_t)(bci * 4 + h) * 64 + tid] = nst; if ((bid & 7) == 0 && tid == 0) mlP[bci * 4 + h] = m;
                        const float mn = fmaxf(bl_[i] + m, ml_[i]); const float so = __expf(bl_[i] + m - mn), sn = __expf(ml_[i] - mn);
                        cst = so * cst + sn * cl[i]; nst = so * nst + sn * nl[i]; m = mn; } }
            }
        } else if (bid < 72) {
            typedef short bf16x8 __attribute__((ext_vector_type(8)));
            const int bh = bid - 64, b = bh >> 2, h = bh & 3;
            constexpr int SLOT = 24576, DEPTH_R = 5;
            PG8_LAS unsigned char* ring = (PG8_LAS unsigned char*)lds;
            const char* gP = (const char*)(rwP + (size_t)((b * NCH) * 4 + h) * 4096); const char* gS = (const char*)(rwS + (size_t)((b * NCH) * 4 + h) * 4096);
            const size_t cstride = (size_t)4 * 4096 * 4;
#define RWC_ISSUE(cc) { const int c_ = ((cc) < NCH) ? (cc) : NCH - 1; const int s_ = (cc) % DEPTH_R; _Pragma("unroll") for (int q = 0; q < 6; ++q) { const int pi = q * 4 + (wave - 4); \
                const char* src = (pi < 8) ? gP + (size_t)c_ * cstride + pi * 1024 + lane * 16 : gS + (size_t)c_ * cstride + (pi - 8) * 1024 + lane * 16; \
                __builtin_amdgcn_global_load_lds((const unsigned*)src, (PG8_LAS unsigned*)(ring + s_ * SLOT + pi * 1024), 16, 0, 0); } }
            f32x4 acc[4];
#pragma unroll
            for (int jt = 0; jt < 4; ++jt) acc[jt] = (f32x4){0.f, 0.f, 0.f, 0.f};
            if (wave >= 4) { RWC_ISSUE(0); RWC_ISSUE(1); RWC_ISSUE(2); RWC_ISSUE(3); }
            const int rl = lane & 15, g = lane >> 4;
            for (int c = 0; c < NCH; ++c) {
                if (wave >= 4) asm volatile("s_waitcnt vmcnt(18)" ::: "memory");
                asm volatile("" ::: "memory"); __builtin_amdgcn_s_barrier(); asm volatile("" ::: "memory");
                if (wave >= 4) { RWC_ISSUE(c + 4); }
                else {
                    const PG8_LAS unsigned char* sl = ring + (c % DEPTH_R) * SLOT;
                    f32x4 lf[4]; bf16x8 af[4][2];
#pragma unroll
                    for (int jt = 0; jt < 4; ++jt) { lf[jt] = *(const PG8_LAS f32x4*)(sl + 8192 + ((wave * 4 + jt) * 64 + lane) * 16);
                        af[jt][0] = *(const PG8_LAS bf16x8*)(sl + ((jt * 2 + 0) * 64 + lane) * 16); af[jt][1] = *(const PG8_LAS bf16x8*)(sl + ((jt * 2 + 1) * 64 + lane) * 16); }
                    float* so = rwS + (size_t)((b * NCH + c) * 4 + h) * 4096 + (size_t)(16 * wave + rl) * 64 + 4 * g;
#pragma unroll
                    for (int jt = 0; jt < 4; ++jt) *(f32x4*)(so + 16 * jt) = acc[jt];
                    bf16x8 bh_[2], bl_[2];
#pragma unroll
                    for (int kk = 0; kk < 2; ++kk) { u32x4 hw, lw; const f32x4 x = acc[2 * kk], y = acc[2 * kk + 1];
                        hw.x = pg8::cvt_pk_bf16(x[0], x[1]); hw.y = pg8::cvt_pk_bf16(x[2], x[3]); hw.z = pg8::cvt_pk_bf16(y[0], y[1]); hw.w = pg8::cvt_pk_bf16(y[2], y[3]);
                        lw.x = pg8::cvt_pk_bf16(x[0] - pg8::bflo(hw.x), x[1] - pg8::bfhi(hw.x)); lw.y = pg8::cvt_pk_bf16(x[2] - pg8::bflo(hw.y), x[3] - pg8::bfhi(hw.y));
                        lw.z = pg8::cvt_pk_bf16(y[0] - pg8::bflo(hw.z), y[1] - pg8::bfhi(hw.z)); lw.w = pg8::cvt_pk_bf16(y[2] - pg8::bflo(hw.w), y[3] - pg8::bfhi(hw.w));
                        bh_[kk] = __builtin_bit_cast(bf16x8, hw); bl_[kk] = __builtin_bit_cast(bf16x8, lw); }
#pragma unroll
                    for (int jt = 0; jt < 4; ++jt) { f32x4 n = lf[jt];
#pragma unroll
                        for (int kk = 0; kk < 2; ++kk) { n = __builtin_amdgcn_mfma_f32_16x16x32_bf16(af[jt][kk], bh_[kk], n, 0, 0, 0); n = __builtin_amdgcn_mfma_f32_16x16x32_bf16(af[jt][kk], bl_[kk], n, 0, 0, 0); }
                        acc[jt] = n; }
                }
            }
            asm volatile("s_waitcnt vmcnt(0)" ::: "memory");
            __builtin_amdgcn_s_barrier();
#undef RWC_ISSUE
        } else if (bid == 128) {
            const int b = tid >> 8, col = tid & 255; float hh = 0.f;
            for (int c0 = 0; c0 < NCH; c0 += 8) {
                float A8[8], H8[8];
#pragma unroll
                for (int i = 0; i < 8; ++i) { const int c = c0 + i; if (c < NCH) { A8[i] = lruA[(b * NCH + c) * 256 + col]; H8[i] = lruH[(b * NCH + c) * 256 + col]; } else { A8[i] = 1.f; H8[i] = 0.f; } }
#pragma unroll
                for (int i = 0; i < 8; ++i) { const int c = c0 + i; if (c < NCH) { lruS[(b * NCH + c) * 256 + col] = hh; hh = A8[i] * hh + H8[i]; } }
            }
        }
        }
#endif

#pragma unroll 1
        for (int it_ = 0; it_ < 3; ++it_) {
            if (it_ == 1) GBAR();
            const int q0_ = G - 1 - bid; const int ui = (it_ == 0) ? (((unsigned)q0_ < 2u) ? 512 + q0_ : -1) : bid + G * (it_ - 1);
            if (ui < 0 || (it_ > 0 && ui >= 512)) continue;
            const int rep_ = 0; (void)rep_;
            const int b = (ui < 512) ? (ui & 1) : (ui - 512), c = (ui < 512) ? 1 + (ui >> 1) : 0;
            const int row0 = (c == 0) ? MMAIN + 64 * b : b * SEQ + 64 * (c - 1), tv0 = (c == 0) ? PADT : 0, bci = b * NCH + c;
            const int hrb = (c == 1) ? MMAIN + 64 * b + 64 : row0;
            int tid = threadIdx.x; asm volatile("" : "+v"(tid)); unsigned char* ws = ws_g; asm volatile("" : "+s"(ws)); unsigned char* dsc = dsc_g; asm volatile("" : "+s"(dsc)); (void)ws; (void)dsc; const int lane = tid & 63, wave = __builtin_amdgcn_readfirstlane(tid >> 6); const int gw = bid * 8 + wave; (void)lane; (void)gw;
            if (c > 0) { u32x4 mv[4], av[4];
#pragma unroll
                for (int i = 0; i < 4; ++i) { const int idx = tid + NTHR * i, t = idx >> 5, c8 = idx & 31; const size_t row = (size_t)(row0 + t);
                    mv[i] = *(const u32x4*)(mix + row * DM + 512 + c8 * 8); av[i] = *(const u32x4*)(acg + row * 256 + c8 * 8); }
#pragma unroll
                for (int i = 0; i < 4; ++i) { const int idx = tid + NTHR * i, t = idx >> 5, c8 = idx & 31; const size_t row = (size_t)(row0 + t);
                    const f32x4 s0 = *(const f32x4*)(lruS + bci * 256 + c8 * 8), s1 = *(const f32x4*)(lruS + bci * 256 + c8 * 8 + 4);
                    u32x4 o; o.x = pk2(pg8::bflo(mv[i].x) + pg8::bflo(av[i].x) * s0[0], pg8::bfhi(mv[i].x) + pg8::bfhi(av[i].x) * s0[1]);
                    o.y = pk2(pg8::bflo(mv[i].y) + pg8::bflo(av[i].y) * s0[2], pg8::bfhi(mv[i].y) + pg8::bfhi(av[i].y) * s0[3]);
                    o.z = pk2(pg8::bflo(mv[i].z) + pg8::bflo(av[i].z) * s1[0], pg8::bfhi(mv[i].z) + pg8::bfhi(av[i].z) * s1[1]);
                    o.w = pk2(pg8::bflo(mv[i].w) + pg8::bflo(av[i].w) * s1[2], pg8::bfhi(mv[i].w) + pg8::bfhi(av[i].w) * s1[3]);
                    *(u32x4*)(mix + row * DM + 512 + c8 * 8) = o; } }
#ifndef NO_SEG_ML3
            {
            int tid = threadIdx.x; asm volatile("" : "+v"(tid)); unsigned char* ws = ws_g; asm volatile("" : "+s"(ws)); unsigned char* dsc = dsc_g; asm volatile("" : "+s"(dsc)); (void)ws; (void)dsc; const int lane = tid & 63; (void)lane;
                typedef short bf16x8 __attribute__((ext_vector_type(8)));
                float* li = L, *bc = L + 256, *mt = L + 512, *wint = L + 768, *np = L + 1024;
                bf16* VT = (bf16*)(L + 2048);
                ml_gates<3>(pbuf, a.in[29], l, row0, tv0, bci, li, bc, nullptr, mt, wint, nullptr, nullptr, mlP, tid);
                { u32x4 vv[4];
#pragma unroll
                  for (int i = 0; i < 4; ++i) { const int idx = tid + NTHR * i, s = idx & 63, c8 = idx >> 6; vv[i] = *(const u32x4*)(pbuf + (size_t)(row0 + s) * DINP + PC_MV + c8 * 8); }
#pragma unroll
                  for (int i = 0; i < 4; ++i) { const int idx = tid + NTHR * i, s = idx & 63, c8 = idx >> 6; bf16* d = VT + (size_t)(c8 * 8) * 72 + s;
                      d[0 * 72] = (bf16)(vv[i].x & 0xffffu); d[1 * 72] = (bf16)(vv[i].x >> 16); d[2 * 72] = (bf16)(vv[i].y & 0xffffu); d[3 * 72] = (bf16)(vv[i].y >> 16);
                      d[4 * 72] = (bf16)(vv[i].z & 0xffffu); d[5 * 72] = (bf16)(vv[i].z >> 16); d[6 * 72] = (bf16)(vv[i].w & 0xffffu); d[7 * 72] = (bf16)(vv[i].w >> 16); }
                  if (tid < 256) np[tid] = (c > 0) ? mlN[(size_t)(bci * 4) * 64 + tid] : 0.f; }
                __syncthreads();
                const int wv_ = tid >> 6, h = wv_ >> 1, th = wv_ & 1, r = lane & 15, g = lane >> 4;
                bf16x8 qf[2][2];
#pragma unroll
                for (int nt = 0; nt < 2; ++nt)
#pragma unroll
                    for (int kk = 0; kk < 2; ++kk) qf[nt][kk] = *(const bf16x8*)(pbuf + (size_t)(row0 + 32 * th + 16 * nt + r) * DINP + PC_MQ + h * 64 + 32 * kk + 8 * g);
                f32x4 accS[4][2];
#pragma unroll
                for (int ms = 0; ms < 4; ++ms) { accS[ms][0] = (f32x4){0.f, 0.f, 0.f, 0.f}; accS[ms][1] = (f32x4){0.f, 0.f, 0.f, 0.f}; }
#pragma unroll
                for (int ms = 0; ms < 4; ++ms)
#pragma unroll
                    for (int kk = 0; kk < 2; ++kk) { const bf16x8 kf = *(const bf16x8*)(pbuf + (size_t)(row0 + 16 * ms + r) * DINP + PC_MK + h * 64 + 32 * kk + 8 * g);
#pragma unroll
                        for (int nt = 0; nt < 2; ++nt) accS[ms][nt] = __builtin_amdgcn_mfma_f32_16x16x32_bf16(kf, qf[nt][kk], accS[ms][nt], 0, 0, 0); }
                float dsum[2], mtt[2], wit[2];
#pragma unroll
                for (int nt = 0; nt < 2; ++nt) { const int t = 32 * th + 16 * nt + r; const float bct = bc[t * 4 + h]; mtt[nt] = mt[t * 4 + h]; wit[nt] = wint[t * 4 + h]; float ds = 0.f;
#pragma unroll
                    for (int ms = 0; ms < 4; ++ms)
#pragma unroll
                        for (int i = 0; i < 4; ++i) { const int s = 16 * ms + 4 * g + i; float e = 0.f;
                            if (s <= t && s >= tv0 && t >= tv0) e = 0.125f * __expf(bct - bc[s * 4 + h] + li[s * 4 + h] - mtt[nt]);
                            const float pv = accS[ms][nt][i] * e; accS[ms][nt][i] = pv; ds += pv; }
                    ds += __shfl_xor(ds, 16); ds += __shfl_xor(ds, 32); dsum[nt] = ds; }
                bf16x8 pf[2][2];
#pragma unroll
                for (int nt = 0; nt < 2; ++nt)
#pragma unroll
                    for (int kk = 0; kk < 2; ++kk) { u32x4 w; w.x = pg8::cvt_pk_bf16(accS[2 * kk][nt][0], accS[2 * kk][nt][1]); w.y = pg8::cvt_pk_bf16(accS[2 * kk][nt][2], accS[2 * kk][nt][3]);
                        w.z = pg8::cvt_pk_bf16(accS[2 * kk + 1][nt][0], accS[2 * kk + 1][nt][1]); w.w = pg8::cvt_pk_bf16(accS[2 * kk + 1][nt][2], accS[2 * kk + 1][nt][3]); pf[nt][kk] = __builtin_bit_cast(bf16x8, w); }
                f32x4 num[4][2];
#pragma unroll
                for (int mv = 0; mv < 4; ++mv) { num[mv][0] = (f32x4){0.f, 0.f, 0.f, 0.f}; num[mv][1] = (f32x4){0.f, 0.f, 0.f, 0.f}; }
#pragma unroll
                for (int mv = 0; mv < 4; ++mv)
#pragma unroll
                    for (int kk = 0; kk < 2; ++kk) { const bf16* vp = VT + (size_t)(h * 64 + 16 * mv + r) * 72 + 32 * kk + 4 * g;
                        typedef unsigned u32x2 __attribute__((ext_vector_type(2)));
                        const u32x2 lo = *(const u32x2*)vp, hi = *(const u32x2*)(vp + 16); u32x4 w; w.x = lo.x; w.y = lo.y; w.z = hi.x; w.w = hi.y; const bf16x8 vf = __builtin_bit_cast(bf16x8, w);
#pragma unroll
                        for (int nt = 0; nt < 2; ++nt) num[mv][nt] = __builtin_amdgcn_mfma_f32_16x16x32_bf16(vf, pf[nt][kk], num[mv][nt], 0, 0, 0); }
                bf16x8 qs[2][2]; float nq[2];
#pragma unroll
                for (int nt = 0; nt < 2; ++nt) { float nqa = 0.f; const float sc = 0.125f * wit[nt];
#pragma unroll
                    for (int kk = 0; kk < 2; ++kk) { const u32x4 w = __builtin_bit_cast(u32x4, qf[nt][kk]);
                        const float f[8] = {pg8::bflo(w.x) * sc, pg8::bfhi(w.x) * sc, pg8::bflo(w.y) * sc, pg8::bfhi(w.y) * sc, pg8::bflo(w.z) * sc, pg8::bfhi(w.z) * sc, pg8::bflo(w.w) * sc, pg8::bfhi(w.w) * sc};
                        const f32x4 n0 = *(const f32x4*)&np[h * 64 + 32 * kk + 8 * g], n1 = *(const f32x4*)&np[h * 64 + 32 * kk + 8 * g + 4];
                        nqa += f[0] * n0.x + f[1] * n0.y + f[2] * n0.z + f[3] * n0.w + f[4] * n1.x + f[5] * n1.y + f[6] * n1.z + f[7] * n1.w;
                        u32x4 o; o.x = pg8::cvt_pk_bf16(f[0], f[1]); o.y = pg8::cvt_pk_bf16(f[2], f[3]); o.z = pg8::cvt_pk_bf16(f[4], f[5]); o.w = pg8::cvt_pk_bf16(f[6], f[7]); qs[nt][kk] = __builtin_bit_cast(bf16x8, o); }
                    nqa += __shfl_xor(nqa, 16); nqa += __shfl_xor(nqa, 32); nq[nt] = nqa; }
#pragma unroll
                for (int mv = 0; mv < 4; ++mv)
#pragma unroll
                    for (int kk = 0; kk < 2; ++kk) { const float* cp = mlC + (size_t)(bci * 4 + h) * 4096 + (size_t)(16 * mv + r) * 64 + 32 * kk + 8 * g;
                        f32x4 c0 = {0.f, 0.f, 0.f, 0.f}, c1 = c0; if (c > 0) { c0 = *(const f32x4*)cp; c1 = *(const f32x4*)(cp + 4); }
                        u32x4 o; o.x = pg8::cvt_pk_bf16(c0.x, c0.y); o.y = pg8::cvt_pk_bf16(c0.z, c0.w); o.z = pg8::cvt_pk_bf16(c1.x, c1.y); o.w = pg8::cvt_pk_bf16(c1.z, c1.w); const bf16x8 cf = __builtin_bit_cast(bf16x8, o);
#pragma unroll
                        for (int nt = 0; nt < 2; ++nt) num[mv][nt] = __builtin_amdgcn_mfma_f32_16x16x32_bf16(cf, qs[nt][kk], num[mv][nt], 0, 0, 0); }
#pragma unroll
                for (int nt = 0; nt < 2; ++nt) { const int t = 32 * th + 16 * nt + r; const size_t row = (size_t)(row0 + t);
                    const float den = dsum[nt] + nq[nt]; const float inv = 1.f / fmaxf(fabsf(den), __expf(-mtt[nt]));
                    float s1 = 0.f;
#pragma unroll
                    for (int mv = 0; mv < 4; ++mv)
#pragma unroll
                        for (int i = 0; i < 4; ++i) { num[mv][nt][i] *= inv; s1 += num[mv][nt][i]; }
                    s1 += __shfl_xor(s1, 16); s1 += __shfl_xor(s1, 32);
                    const float mean = s1 * (1.f / 64.f); float s2 = 0.f;
#pragma unroll
                    for (int mv = 0; mv < 4; ++mv)
#pragma unroll
                        for (int i = 0; i < 4; ++i) { num[mv][nt][i] -= mean; s2 += num[mv][nt][i] * num[mv][nt][i]; }
                    s2 += __shfl_xor(s2, 16); s2 += __shfl_xor(s2, 32);
                    const float rstd = 1.f / sqrtf(s2 * (1.f / 64.f) + GN_EPS);
#pragma unroll
                    for (int mv = 0; mv < 4; ++mv) { const int v0 = h * 64 + 16 * mv + 4 * g;
                        typedef unsigned u32x2 __attribute__((ext_vector_type(2)));
                        const u32x2 ov = *(const u32x2*)(pbuf + row * DINP + PC_MO + v0);
                        const f32x4 gg = *(const f32x4*)(a.in[30] + l * 256 + v0), gb = *(const f32x4*)(a.in[31] + l * 256 + v0);
                        float y[4]; const float o4[4] = {pg8::bflo(ov.x), pg8::bfhi(ov.x), pg8::bflo(ov.y), pg8::bfhi(ov.y)};
#pragma unroll
                        for (int i = 0; i < 4; ++i) { y[i] = (num[mv][nt][i] * rstd * gg[i] + gb[i]) * sigmoidf_(o4[i]); if (t < tv0) y[i] = 0.f; }
                        u32x2 ow; ow.x = pk2(y[0], y[1]); ow.y = pk2(y[2], y[3]);
                        *(u32x2*)(mix + row * DM + 768 + v0) = ow; }
                }
                __syncthreads();
            }
#endif
#ifndef NO_SEG_RW3
            {
            int tid = threadIdx.x; asm volatile("" : "+v"(tid)); unsigned char* ws = ws_g; asm volatile("" : "+s"(ws)); unsigned char* dsc = dsc_g; asm volatile("" : "+s"(dsc)); (void)ws; (void)dsc; const int lane = tid & 63; (void)lane;
                const int wv_ = __builtin_amdgcn_readfirstlane(tid >> 6);
                int ui_l = __builtin_amdgcn_readfirstlane(ui); asm volatile("" : "+s"(ui_l)); const bf16* LO = (const bf16*)(ws + WS_LORA) + (size_t)ui_l * 64 * 256 * 4;
                { unsigned z0; asm volatile("v_mov_b32 %0, 0" : "=v"(z0)); const u32x4 zz = {z0, z0, z0, z0}; for (int i = tid; i < WY_UVB / 16; i += NTHR) ((u32x4*)(lds + WY_UV))[i] = zz; }
                const int h = wv_ & 3, r = lane & 15, g = lane >> 4;
                f32x4 acc[4][4];
                if (wv_ < 4) { const float* src = rwS + (size_t)(bci * 4 + h) * 4096;
#pragma unroll
                    for (int jt = 0; jt < 4; ++jt)
#pragma unroll
                        for (int rt = 0; rt < 4; ++rt) { f32x4 x = {0.f, 0.f, 0.f, 0.f}; if (c > 0) x = *(const f32x4*)(src + (size_t)(16 * rt + r) * 64 + 16 * jt + 4 * g); acc[jt][rt] = x; } }
                else { float z0; asm volatile("v_mov_b32 %0, 0" : "=v"(z0));
#pragma unroll
                    for (int jt = 0; jt < 4; ++jt)
#pragma unroll
                        for (int rt = 0; rt < 4; ++rt) acc[jt][rt] = (f32x4){z0, z0, z0, z0}; }
                __syncthreads();
                for (int blk = 0; blk < 4; ++blk) {
                    const int ts = blk * 16;
                    if (ts + 16 <= tv0) { if (tid < 256) { for (int j = 0; j < 16; ++j) mix[(size_t)(row0 + ts + j) * DM + 256 + tid] = 0; } continue; }
                    wy_prep<3>(a, pbuf, vfirst, LO, lds, l, c, row0, hrb, ts, tid);
                    if (wv_ < 4) { int r0_ = __builtin_amdgcn_readfirstlane(row0 + ts); asm volatile("" : "+s"(r0_)); wy_block<3>(acc, lds, h, lane, (bf16*)(lds + WY_UV) + (size_t)h * 64 * WY_TS, lds + WY_SCR + h * WY_WSCR, (float*)(lds + WY_SCR + h * WY_WSCR + 3584), mix + (size_t)r0_ * DM + 256 + h * 64, a.in[17] + l * 256 + h * 64, a.in[18] + l * 256 + h * 64); }
                    __syncthreads();
                }
            }
#endif
        }
        GBAR();

        { pg8::Gemm g{mix, (const bf16*)(wl + LW_OUT), MMAIN, DM, DM}; pg8::StaticOrder S; S.init(MMAIN, DM, G, bid);
          pg8::EpiResid E{hb, DM, ALPHA};
          pg8::gemm_phase<pg8::EpiResid, pg8::StaticOrder, true, true>((PG8_LAS unsigned char*)lds, g, S, E); }
        side_gemm<1>(mix + (size_t)MMAIN * DM, (const bf16*)(wl + LW_OUT), DM, DM, hb + (size_t)MMAIN * DM, DM, ALPHA, lds, bid, G);
        GBAR();
        { int tid = threadIdx.x; asm volatile("" : "+v"(tid)); unsigned char* ws = ws_g; asm volatile("" : "+s"(ws)); unsigned char* dsc = dsc_g; asm volatile("" : "+s"(dsc)); (void)ws; (void)dsc; const int lane = tid & 63, wave = __builtin_amdgcn_readfirstlane(tid >> 6); const int gw = bid * 8 + wave; (void)lane; (void)gw;
        for (int m = gw; m < MP; m += NGW) ln_row_bf16(hb + (size_t)m * DM, a.in[32] + l * DM, a.in[33] + l * DM, nullptr, lane);
        }
        GBAR();
        { pg8::Gemm g{hb, (const bf16*)(wl + LW_1), MMAIN, FF, DM}; pg8::StaticOrder S; S.init(MMAIN, FF, G, bid);
          pg8::EpiStore<2> E{ffh, FF};
          pg8::gemm_phase<pg8::EpiStore<2>, pg8::StaticOrder, true, true>((PG8_LAS unsigned char*)lds, g, S, E); }
        side_gemm<2>(hb + (size_t)MMAIN * DM, (const bf16*)(wl + LW_1), DM, FF, ffh + (size_t)MMAIN * FF, FF, 0.f, lds, bid, G);
        GBAR();
        { pg8::Gemm g{ffh, (const bf16*)(wl + LW_2), MMAIN, DM, FF}; pg8::StaticOrder S; S.init(MMAIN, DM, G, bid);
          pg8::EpiResid E{hb, DM, ALPHA};
          pg8::gemm_phase<pg8::EpiResid, pg8::StaticOrder, true, true>((PG8_LAS unsigned char*)lds, g, S, E); }
        side_gemm<1>(ffh + (size_t)MMAIN * FF, (const bf16*)(wl + LW_2), FF, DM, hb + (size_t)MMAIN * DM, DM, ALPHA, lds, bid, G);
        GBAR();
        { int tid = threadIdx.x; asm volatile("" : "+v"(tid)); unsigned char* ws = ws_g; asm volatile("" : "+s"(ws)); unsigned char* dsc = dsc_g; asm volatile("" : "+s"(dsc)); (void)ws; (void)dsc; const int lane = tid & 63, wave = __builtin_amdgcn_readfirstlane(tid >> 6); const int gw = bid * 8 + wave; (void)lane; (void)gw;
        if (l < DEPTH - 1) { for (int m = gw; m < MP; m += NGW) ln_row_bf16(hb + (size_t)m * DM, a.in[34] + l * DM, a.in[35] + l * DM, nullptr, lane); }
        else { for (int m = gw; m < NB * SEQ; m += NGW) ln_row_bf16(hb + (size_t)m * DM, a.in[34] + l * DM, a.in[35] + l * DM, a.out + (size_t)m * DM, lane); }
        }
        if (l < DEPTH - 1) GBAR();
    }
}

#undef hb
#undef pbuf
#undef mix
#undef acg
#undef ffh
#undef lruA
#undef lruH
#undef lruS
#undef mlN
#undef mlM
#undef mlB
#undef mlP
#undef vfirst
#undef rwP
#undef rwS
#undef mlC
extern "C" void kernel_launch(void* const* d_in, const int* in_sizes, int n_in, void* d_out, int out_size, void* d_ws, size_t ws_size, hipStream_t stream) {
    static int grid = 0;
    if (grid == 0) {
        if (n_in != 38 || out_size != NB * SEQ * DM || ws_size < WS_END) { fprintf(stderr, "kernel_launch: unexpected sizes n_in %d out %d ws %zu (need %zu)\n", n_in, out_size, ws_size, (size_t)WS_END); grid = -1; return; }
        int dev = 0, cus = 0, per_cu = 0;
        hipGetDevice(&dev); hipDeviceGetAttribute(&cus, hipDeviceAttributeMultiprocessorCount, dev);
        if (hipFuncSetAttribute((const void*)hybrid_fwd, hipFuncAttributeMaxDynamicSharedMemorySize, LDS_BYTES) != hipSuccess) { fprintf(stderr, "kernel_launch: hipFuncSetAttribute failed\n"); grid = -1; return; }
        if (hipOccupancyMaxActiveBlocksPerMultiprocessor(&per_cu, (const void*)hybrid_fwd, NTHR, LDS_BYTES) != hipSuccess || per_cu < 1) { fprintf(stderr, "kernel_launch: occupancy query says %d\n", per_cu); per_cu = 1; }
        (void)hipGetLastError();
        grid = cus * 1;
    }
    if (grid < 0) return;
    if (hipMemsetAsync((char*)d_ws + WS_BAR, 0, BAR_BYTES, stream) != hipSuccess) { fprintf(stderr, "kernel_launch: memset of the barrier words failed\n"); return; }
    Args a{};
    for (int i = 0; i < 38; ++i) a.in[i] = (const float*)d_in[i];
    a.out = (float*)d_out; a.ws = (unsigned char*)d_ws;
    void* args[] = {&a};
    hipError_t e = hipLaunchCooperativeKernel((const void*)hybrid_fwd, dim3(grid), dim3(NTHR), args, LDS_BYTES, stream);
    if (e != hipSuccess) fprintf(stderr, "cooperative launch failed: %s (grid %d)\n", hipGetErrorString(e), grid);
}
```

```cpp
#include <hip/hip_runtime.h>
#include <hip/hip_cooperative_groups.h>
#include <cstdio>
#include <cstdint>
namespace cg = cooperative_groups;
namespace pg8 {
#define PG8_LAS __attribute__((address_space(3)))
typedef unsigned short bf16_t;
typedef short bf16x8 __attribute__((ext_vector_type(8)));
typedef float f32x4 __attribute__((ext_vector_type(4)));
typedef unsigned u32x4 __attribute__((ext_vector_type(4)));
constexpr int BM = 256, BK = 64, HALF = 128, HTB = HALF * BK * 2  , STAGE_BYTES = 8 * HTB, NXCD = 8, WGM = 4;

__host__ __device__ __forceinline__ int lds_byte(int r, int c) { const int st = (r >> 4) * 2 + (c >> 5), rr = r & 15, cc = c & 31, ob = rr * 64 + cc * 2; return st * 1024 + (ob ^ (((ob >> 9) & 1) << 5)); }
__host__ __device__ __forceinline__ void stage_rc(int b, int& R, int& C) { const int st = b / 1024, sb = b % 1024, swz = sb ^ (((sb >> 9) & 1) << 5); R = (st >> 1) * 16 + swz / 64; C = (st & 1) * 32 + (swz % 64) / 2; }
__host__ __device__ __forceinline__ int perm32(int rho) { const int n = rho >> 4, i = rho & 15; return 8 * (i >> 2) + 4 * n + (i & 3); }

struct Unit { int pm, pn; };
struct Gemm { const bf16_t* A; const bf16_t* Bt; int M, N, K; };

struct StaticOrder {
    int nM, nN, nwg, G, c;
    __host__ __device__ void init(int M, int N, int G_, int c_) { nM = M / BM; nN = N / BM; nwg = nM * nN; G = G_; c = c_; }
    __host__ __device__ bool next(int i, Unit& u) const {
        const long L = (long)i * G + c; if (L >= nwg) return false;
        int wgid = (int)L; { const int q = nwg / NXCD, r = nwg % NXCD, xcd = wgid % NXCD, off = wgid / NXCD; wgid = (xcd < r ? xcd * (q + 1) : r * (q + 1) + (xcd - r) * q) + off; }
        const int nig = WGM * nN, gid = wgid / nig, fm = gid * WGM, gsz = (nM - fm) < WGM ? (nM - fm) : WGM;
        u.pm = fm + ((wgid % nig) % gsz); u.pn = (wgid % nig) / gsz; return true;
    }
    __device__ __forceinline__ void a_ready(const Unit&) const {}
    __device__ __forceinline__ void done(const Unit&) const {}
};


__device__ __forceinline__ unsigned cvt_pk_bf16(float lo, float hi) { unsigned r; asm volatile("v_cvt_pk_bf16_f32 %0, %1, %2" : "=v"(r) : "v"(lo), "v"(hi)); return r; }
__device__ __forceinline__ float bflo(unsigned w) { return __builtin_bit_cast(float, w << 16); }
__device__ __forceinline__ float bfhi(unsigned w) { return __builtin_bit_cast(float, w & 0xffff0000u); }

template <int ACT> struct EpiStore {
    static constexpr bool PERM = true, AFTER_DRAIN = false;
    bf16_t* O; int ldc;
    __device__ __forceinline__ void operator()(const f32x4 (&acc)[2][2][4][2], const Unit& u, int wr, int wc, int fr, int fq) const {
        const int row0 = u.pm * BM + wr * 64 + fr; const int col0 = u.pn * BM + wc * 32 + 8 * fq;
#pragma unroll
        for (int ai = 0; ai < 2; ++ai)
#pragma unroll
            for (int m = 0; m < 4; ++m) { bf16_t* rowp = O + (size_t)(row0 + ai * HALF + m * 16) * ldc + col0;
#pragma unroll
                for (int bj = 0; bj < 2; ++bj) { f32x4 v0 = acc[ai][bj][m][0], v1 = acc[ai][bj][m][1];
                    if (ACT == 2) {
#pragma unroll
                        for (int q = 0; q < 4; ++q) { float a = v0[q] > 0.f ? v0[q] : 0.f; v0[q] = a * a; float b = v1[q] > 0.f ? v1[q] : 0.f; v1[q] = b * b; } }
                    u32x4 w; w.x = cvt_pk_bf16(v0[0], v0[1]); w.y = cvt_pk_bf16(v0[2], v0[3]); w.z = cvt_pk_bf16(v1[0], v1[1]); w.w = cvt_pk_bf16(v1[2], v1[3]);
                    *(u32x4*)(rowp + bj * HALF) = w; } }
    }
};
struct EpiResid {
    static constexpr bool PERM = true, AFTER_DRAIN = false;
    bf16_t* H; int ldc; float alpha;
    __device__ __forceinline__ void operator()(const f32x4 (&acc)[2][2][4][2], const Unit& u, int wr, int wc, int fr, int fq) const {
        const int row0 = u.pm * BM + wr * 64 + fr; const int col0 = u.pn * BM + wc * 32 + 8 * fq;
#pragma unroll
        for (int ai = 0; ai < 2; ++ai)
#pragma unroll
            for (int m = 0; m < 4; ++m) { bf16_t* rowp = H + (size_t)(row0 + ai * HALF + m * 16) * ldc + col0;
#pragma unroll
                for (int bj = 0; bj < 2; ++bj) { const f32x4 v0 = acc[ai][bj][m][0], v1 = acc[ai][bj][m][1];
                    const u32x4 o = *(const u32x4*)(rowp + bj * HALF);
                    u32x4 w;
                    w.x = cvt_pk_bf16(alpha * bflo(o.x) + v0[0], alpha * bfhi(o.x) + v0[1]);
                    w.y = cvt_pk_bf16(alpha * bflo(o.y) + v0[2], alpha * bfhi(o.y) + v0[3]);
                    w.z = cvt_pk_bf16(alpha * bflo(o.z) + v1[0], alpha * bfhi(o.z) + v1[1]);
                    w.w = cvt_pk_bf16(alpha * bflo(o.w) + v1[2], alpha * bfhi(o.w) + v1[3]);
                    *(u32x4*)(rowp + bj * HALF) = w; } }
    }
};

template <class Epi, class Sched, bool ALIGN_EPI = false, bool SP2 = false>
__device__ __forceinline__ void gemm_phase(PG8_LAS unsigned char* lds, const Gemm g, const Sched& S, const Epi& E) {
    int tid_o = threadIdx.x; asm volatile("" : "+v"(tid_o));
    const int tid = tid_o, wid = __builtin_amdgcn_readfirstlane(tid >> 6), lane = tid & 63, wr = wid >> 2, wc = wid & 3, fr = lane & 15, fq = lane >> 4;
    const int K = g.K, nt = K / BK;
    unsigned voffA[2], voffB[2];
#pragma unroll
    for (int i = 0; i < 2; ++i) { int R, C; stage_rc(tid * 16 + i * 8192, R, C); const int Rb = Epi::PERM ? ((R & ~31) + perm32(R & 31)) : R;
        voffA[i] = (unsigned)(R * K + C) * 2u; voffB[i] = (unsigned)(Rb * K + C) * 2u; }
    const size_t kstep = (size_t)(BK * 2);
    const size_t hstep = (size_t)HALF * K * 2;
    const size_t tstep = 2 * hstep;
    const unsigned ldsw = (unsigned)wid * 1024u;
    const int aoff = lds_byte(wr * 64 + fr, fq * 8), boff = lds_byte(wc * 32 + fr, fq * 8);
#define PG8_SA(b, h) (((b) * 2 + (h)) * HTB)
#define PG8_SB(b, h) ((4 + (b) * 2 + (h)) * HTB)
#define PG8_STAGE(bufoff, gbase, voff) do { _Pragma("unroll") for (int _i = 0; _i < 2; ++_i) \
        __builtin_amdgcn_global_load_lds((const unsigned*)((const char*)(gbase) + (voff)[_i]), (PG8_LAS unsigned*)(lds + (bufoff) + ldsw + _i * 8192), 16, 0, 0); } while (0)
#define PG8_LDA(dst, b, h) do { _Pragma("unroll") for (int m = 0; m < 4; ++m) _Pragma("unroll") for (int k = 0; k < 2; ++k) dst[m][k] = *(const PG8_LAS bf16x8*)(lds + PG8_SA(b, h) + aoff + m * 2048 + k * 1024); } while (0)
#define PG8_LDB(dst, b, h) do { _Pragma("unroll") for (int n = 0; n < 2; ++n) _Pragma("unroll") for (int k = 0; k < 2; ++k) dst[n][k] = *(const PG8_LAS bf16x8*)(lds + PG8_SB(b, h) + boff + n * 2048 + k * 1024); } while (0)
#define PG8_MMA(ai, bj, At, Bt) do { __builtin_amdgcn_s_setprio(1); _Pragma("unroll") for (int m = 0; m < 4; ++m) _Pragma("unroll") for (int n = 0; n < 2; ++n) _Pragma("unroll") for (int k = 0; k < 2; ++k) \
        acc[ai][bj][m][n] = __builtin_amdgcn_mfma_f32_16x16x32_bf16(Bt[n][k], At[m][k], acc[ai][bj][m][n], 0, 0, 0); __builtin_amdgcn_s_setprio(0); } while (0)
#define PG8_WAIT_V(n) asm volatile("s_waitcnt vmcnt(" #n ")" ::: "memory")
#define PG8_WAIT_L(n) asm volatile("s_waitcnt lgkmcnt(" #n ")" ::: "memory")
#define PG8_BAR __builtin_amdgcn_s_barrier()
#define PG8_SCHED __builtin_amdgcn_sched_barrier(0)
    Unit cur, nxt; int ui = 0;
    if (!S.next(0, cur)) return;
    f32x4 acc[2][2][4][2];
#pragma unroll
    for (int a = 0; a < 2; ++a)
#pragma unroll
        for (int b = 0; b < 2; ++b)
#pragma unroll
            for (int m = 0; m < 4; ++m)
#pragma unroll
                for (int n = 0; n < 2; ++n) acc[a][b][m][n] = (f32x4){0.f, 0.f, 0.f, 0.f};
    bf16x8 At[4][2], B0[2][2], B1[2][2];
    const char* cA = (const char*)g.A + (size_t)cur.pm * tstep; const char* cB = (const char*)g.Bt + (size_t)cur.pn * tstep;
    S.a_ready(cur);
    if constexpr (SP2) {
        PG8_STAGE(PG8_SB(0, 0), cB, voffB); PG8_STAGE(PG8_SB(0, 1), cB + hstep, voffB); PG8_STAGE(PG8_SA(0, 0), cA, voffA); PG8_STAGE(PG8_SA(0, 1), cA + hstep, voffA);
        if (wr == 1) PG8_BAR;
        PG8_WAIT_V(2); PG8_BAR;
        PG8_STAGE(PG8_SB(1, 0), cB + kstep, voffB); PG8_STAGE(PG8_SA(1, 0), cA + kstep, voffA); PG8_STAGE(PG8_SB(1, 1), cB + hstep + kstep, voffB);
        PG8_WAIT_V(6); PG8_BAR;
    } else {
        PG8_STAGE(PG8_SB(0, 0), cB, voffB); PG8_STAGE(PG8_SA(0, 0), cA, voffA); PG8_STAGE(PG8_SB(0, 1), cB + hstep, voffB); PG8_STAGE(PG8_SA(0, 1), cA + hstep, voffA);
        if (wr == 1) PG8_BAR;
        PG8_WAIT_V(4); PG8_BAR;
        PG8_STAGE(PG8_SB(1, 0), cB + kstep, voffB); PG8_STAGE(PG8_SA(1, 0), cA + kstep, voffA); PG8_STAGE(PG8_SB(1, 1), cB + hstep + kstep, voffB);
        PG8_WAIT_V(6); PG8_BAR;
    }
    for (;;) {
        const bool has_next = S.next(ui + 1, nxt);
        const char* nA = has_next ? (const char*)g.A + (size_t)nxt.pm * tstep : cA; const char* nB = has_next ? (const char*)g.Bt + (size_t)nxt.pn * tstep : cB;
        for (int t = 0; t < nt; t += 2) {
            const bool last = (t == nt - 2);
            const char* a1 = cA + (size_t)(t + 1) * kstep;
            const char* a2 = last ? nA : cA + (size_t)(t + 2) * kstep; const char* b2 = last ? nB : cB + (size_t)(t + 2) * kstep;
            const char* a3 = a2 + kstep; const char* b3 = b2 + kstep;
            if (last && has_next) S.a_ready(nxt);
            if constexpr (SP2) {
            PG8_LDB(B0, 0, 0); PG8_LDB(B1, 0, 1); PG8_SCHED; PG8_LDA(At, 0, 0); PG8_STAGE(PG8_SA(1, 1), a1 + hstep, voffA);
            PG8_WAIT_V(8); PG8_WAIT_L(0); PG8_BAR; PG8_MMA(0, 0, At, B0); PG8_MMA(0, 1, At, B1); PG8_BAR; PG8_SCHED;
            PG8_LDA(At, 0, 1); PG8_STAGE(PG8_SB(0, 0), b2, voffB); PG8_STAGE(PG8_SB(0, 1), b2 + hstep, voffB); PG8_STAGE(PG8_SA(0, 0), a2, voffA);
            PG8_WAIT_V(8); PG8_WAIT_L(0); PG8_BAR; PG8_MMA(1, 0, At, B0); PG8_MMA(1, 1, At, B1); PG8_BAR; PG8_SCHED;
            PG8_LDB(B0, 1, 0); PG8_LDB(B1, 1, 1); PG8_SCHED; PG8_LDA(At, 1, 0); PG8_STAGE(PG8_SA(0, 1), a2 + hstep, voffA);
            PG8_WAIT_V(8); PG8_WAIT_L(0); PG8_BAR; PG8_MMA(0, 0, At, B0); PG8_MMA(0, 1, At, B1); PG8_BAR; PG8_SCHED;
            PG8_LDA(At, 1, 1); PG8_STAGE(PG8_SB(1, 0), b3, voffB); PG8_STAGE(PG8_SB(1, 1), b3 + hstep, voffB); PG8_STAGE(PG8_SA(1, 0), a3, voffA);
            PG8_WAIT_V(8); PG8_WAIT_L(0); PG8_BAR; PG8_MMA(1, 0, At, B0); PG8_MMA(1, 1, At, B1); PG8_BAR; PG8_SCHED;
            } else {
            PG8_LDB(B0, 0, 0); PG8_SCHED; PG8_LDA(At, 0, 0); PG8_STAGE(PG8_SA(1, 1), a1 + hstep, voffA);
            PG8_WAIT_L(8); PG8_BAR; PG8_WAIT_L(0); PG8_MMA(0, 0, At, B0); PG8_BAR; PG8_SCHED;
            PG8_LDB(B1, 0, 1); PG8_STAGE(PG8_SB(0, 0), b2, voffB);
            PG8_BAR; PG8_WAIT_L(0); PG8_MMA(0, 1, At, B1); PG8_BAR;
            PG8_LDA(At, 0, 1); PG8_STAGE(PG8_SA(0, 0), a2, voffA);
            PG8_BAR; PG8_WAIT_L(0); PG8_MMA(1, 0, At, B0); PG8_BAR; PG8_SCHED;
            PG8_STAGE(PG8_SB(0, 1), b2 + hstep, voffB);
            PG8_WAIT_V(6); PG8_BAR; PG8_MMA(1, 1, At, B1); PG8_BAR;
            PG8_LDB(B0, 1, 0); PG8_SCHED; PG8_LDA(At, 1, 0); PG8_STAGE(PG8_SA(0, 1), a2 + hstep, voffA);
            PG8_WAIT_L(8); PG8_BAR; PG8_WAIT_L(0); PG8_MMA(0, 0, At, B0); PG8_BAR; PG8_SCHED;
            PG8_LDB(B1, 1, 1); PG8_STAGE(PG8_SB(1, 0), b3, voffB);
            PG8_BAR; PG8_WAIT_L(0); PG8_MMA(0, 1, At, B1); PG8_BAR;
            PG8_LDA(At, 1, 1); PG8_STAGE(PG8_SA(1, 0), a3, voffA);
            PG8_BAR; PG8_WAIT_L(0); PG8_MMA(1, 0, At, B0); PG8_BAR; PG8_SCHED;
            PG8_STAGE(PG8_SB(1, 1), b3 + hstep, voffB);
            PG8_WAIT_V(6); PG8_BAR; PG8_MMA(1, 1, At, B1); PG8_BAR;
            }
        }
        if constexpr (ALIGN_EPI) { if (wr == 0) PG8_BAR; }
        if constexpr (!Epi::AFTER_DRAIN) { E(acc, cur, wr, wc, fr, fq); S.done(cur); }
        if (!has_next) break;
#pragma unroll
        for (int a = 0; a < 2; ++a)
#pragma unroll
            for (int b = 0; b < 2; ++b)
#pragma unroll
                for (int m = 0; m < 4; ++m)
#pragma unroll
                    for (int n = 0; n < 2; ++n) acc[a][b][m][n] = (f32x4){0.f, 0.f, 0.f, 0.f};
        cur = nxt; cA = nA; cB = nB; ++ui;
        if constexpr (ALIGN_EPI) { if (wr == 1) PG8_BAR; }
    }
    PG8_WAIT_V(0);
    if constexpr (!ALIGN_EPI) { if (wr == 0) PG8_BAR; }
    PG8_BAR;
    if constexpr (Epi::AFTER_DRAIN) { E.fused(acc, cur, wr, wc, fr, fq, lds, wid, lane); S.done(cur); }
#undef PG8_SA
#undef PG8_SB
#undef PG8_STAGE
#undef PG8_LDA
#undef PG8_LDB
#undef PG8_MMA
#undef PG8_WAIT_V
#undef PG8_WAIT_L
#undef PG8_BAR
#undef PG8_SCHED
}
}

typedef unsigned short bf16;
typedef float f32x4 __attribute__((ext_vector_type(4)));
typedef unsigned u32x4 __attribute__((ext_vector_type(4)));
constexpr int NTHR = 512;
constexpr int NB = 2, SEQ = 16384, NMETA = 16, DM = 1024, DEPTH = 4;
constexpr int TP = 16448, PADT = 48, NCH = 257, MR = NB * TP, MP = 33024;
constexpr int DIN = 2696, DINP = 2816, FF = 4096, GWD = 256;
constexpr int MMAIN = NB * SEQ;
constexpr float ALPHA = 1.6817928305074292f;
constexpr float LN_EPS = 1e-5f, GN_EPS = 64e-5f;
constexpr int PC_POOL = 0, PC_RW = 256, PC_LX = 1152, PC_LG = 1408, PC_MQ = 1664, PC_MK = 1920, PC_MV = 2176, PC_MO = 2432, PC_MI = 2688, PC_MF = 2692;
constexpr size_t LW_IN = 0, LW_OUT = (size_t)DINP * DM * 2, LW_1 = LW_OUT + (size_t)DM * DM * 2, LW_2 = LW_1 + (size_t)FF * DM * 2, LW_SZ = LW_2 + (size_t)DM * FF * 2;
constexpr size_t WS_W = 0;
constexpr size_t WS_HB = WS_W + 4 * LW_SZ;
constexpr size_t WS_U = WS_HB + (size_t)MP * DM * 2;
constexpr size_t U_P = 0, U_MIX = (size_t)MP * DINP * 2, U_ACG = U_MIX + (size_t)MP * DM * 2, U_SZ = (size_t)MP * FF * 2;
static_assert(U_ACG + (size_t)MP * GWD * 2 <= U_SZ, "U map");
constexpr size_t WS_LRUA = WS_U + U_SZ;
constexpr size_t WS_LRUH = WS_LRUA + (size_t)NB * NCH * GWD * 4;
constexpr size_t WS_LRUS = WS_LRUH + (size_t)NB * NCH * GWD * 4;
constexpr size_t WS_MLN = WS_LRUS + (size_t)NB * NCH * GWD * 4;
constexpr size_t WS_MLM = WS_MLN + (size_t)NB * NCH * 4 * 64 * 4;
constexpr size_t WS_MLB = WS_MLM + (size_t)NB * NCH * 4 * 4;
constexpr size_t WS_MLP = WS_MLB + (size_t)NB * NCH * 4 * 4;
constexpr size_t WS_LORA = (WS_MLP + (size_t)NB * NCH * 4 * 4 + 255) / 256 * 256;
constexpr size_t WS_WT3 = (WS_LORA + (size_t)514 * 64 * 256 * 8 + 255) / 256 * 256;
constexpr size_t WS_WT4 = WS_WT3 + (size_t)DEPTH * 3 * 4 * 4096 * 2;
constexpr size_t WS_PAR = WS_WT4 + (size_t)DEPTH * 49152 * 2;
constexpr int PAR_TOTAL = 416032;
constexpr size_t WS_BAR = (WS_PAR + (size_t)PAR_TOTAL * 4 + 255) / 256 * 256;
constexpr size_t BAR_BYTES = 16384;
constexpr size_t WS_END = WS_BAR + BAR_BYTES;
constexpr size_t DO_VF = 0;
constexpr size_t DO_RWP = DO_VF + (size_t)MP * GWD * 2;
constexpr size_t DO_RWS = DO_RWP + (size_t)NB * NCH * 4 * 4096 * 4;
constexpr size_t DO_MLC = DO_RWS + (size_t)NB * NCH * 4 * 4096 * 4;
constexpr size_t DO_END = DO_MLC + (size_t)NB * NCH * 4 * 4096 * 4;
static_assert(DO_END <= (size_t)NB * SEQ * DM * 4, "d_out scratch");
constexpr int LDS_BYTES = 147456;
#ifndef PB_REP
#define PB_REP 1
#endif
#ifndef PD_REP
#define PD_REP 1
#endif

struct Args { const float* in[38]; float* out; unsigned char* ws; };

__device__ __forceinline__ unsigned f2bf(float f) { unsigned u = __builtin_bit_cast(unsigned, f); return (u + 0x7fffu + ((u >> 16) & 1u)) >> 16; }
__device__ __forceinline__ unsigned pk2(float lo, float hi) { return f2bf(lo) | (f2bf(hi) << 16); }
__device__ __forceinline__ float bf2f(bf16 v) { return __builtin_bit_cast(float, (unsigned)v << 16); }
__device__ __forceinline__ float row16_sum(float v) {
#define WS_DPP(ctrl) { const int t_ = __builtin_amdgcn_update_dpp(0, __builtin_bit_cast(int, v), ctrl, 0xf, 0xf, false); v += __builtin_bit_cast(float, t_); }
    WS_DPP(0xB1) WS_DPP(0x4E) WS_DPP(0x141) WS_DPP(0x140)
#undef WS_DPP
    return v;
}
__device__ __forceinline__ float wave_sum(float v) {
#define WS_DPP(ctrl, rmask) { const int t_ = __builtin_amdgcn_update_dpp(0, __builtin_bit_cast(int, v), ctrl, rmask, 0xf, false); v += __builtin_bit_cast(float, t_); }
    WS_DPP(0xB1, 0xf) WS_DPP(0x4E, 0xf) WS_DPP(0x141, 0xf) WS_DPP(0x140, 0xf) WS_DPP(0x142, 0xa) WS_DPP(0x143, 0xc)
#undef WS_DPP
    return __builtin_bit_cast(float, __builtin_amdgcn_readlane(__builtin_bit_cast(int, v), 63));
}
__device__ __forceinline__ float frcp_(float x) { return __builtin_amdgcn_rcpf(x); }
__device__ __forceinline__ float frsq_(float x) { return __builtin_amdgcn_rsqf(x); }
__device__ __forceinline__ float sigmoidf_(float x) { return frcp_(1.f + __expf(-x)); }
__device__ __forceinline__ float tanhf_(float x) { return 1.f - 2.f * frcp_(__expf(2.f * x) + 1.f); }
__device__ __forceinline__ float softplusf_(float x) { return fmaxf(x, 0.f) + __logf(1.f + __expf(-fabsf(x))); }
__device__ __forceinline__ float logsigmoidf_(float x) { return fminf(x, 0.f) - __logf(1.f + __expf(-fabsf(x))); }
__device__ __forceinline__ float gelu_tanh(float x) { return 0.5f * x * (1.f + tanhf_(0.7978845608028654f * (x + 0.044715f * x * x * x))); }
#define LDS_WAIT() asm volatile("s_waitcnt lgkmcnt(0)" ::: "memory")

__device__ __forceinline__ void transpose_item(const float* W, int K, int N, int NP, bf16* WT, float* scr, int item, int lane) {
    const int nblk = NP / 32, kb = item / nblk, nb = item % nblk, k0 = 64 * kb, n0 = 32 * nb;
#pragma unroll 8
    for (int i = 0; i < 32; ++i) { const int kk = 2 * i + (lane >> 5); const int n = n0 + (lane & 31); scr[kk * 33 + (lane & 31)] = (n < N) ? W[(size_t)(k0 + kk) * N + n] : 0.f; }
    LDS_WAIT(); asm volatile("" ::: "memory");
    const int c = lane & 7;
#pragma unroll
    for (int j = 0; j < 4; ++j) { const int n = (lane >> 3) + 8 * j; const float* s = scr + (8 * c) * 33 + n;
        u32x4 o; o.x = pk2(s[0 * 33], s[1 * 33]); o.y = pk2(s[2 * 33], s[3 * 33]); o.z = pk2(s[4 * 33], s[5 * 33]); o.w = pk2(s[6 * 33], s[7 * 33]);
        *(u32x4*)(WT + (size_t)(n0 + n) * K + k0 + 8 * c) = o; }
    LDS_WAIT(); asm volatile("" ::: "memory");
}
__device__ __forceinline__ void ln_row_f32_to_bf16(const float* xrow, const float* g, const float* bb, bf16* orow, int lane) {
    const f32x4* xr = (const f32x4*)xrow + lane;
    f32x4 v[4]; float s = 0.f;
#pragma unroll
    for (int j = 0; j < 4; ++j) { v[j] = xr[64 * j]; s += (v[j].x + v[j].y) + (v[j].z + v[j].w); }
    const float mean = wave_sum(s) * (1.f / DM); float s2 = 0.f;
#pragma unroll
    for (int j = 0; j < 4; ++j) { v[j] = v[j] - mean; s2 += (v[j].x * v[j].x + v[j].y * v[j].y) + (v[j].z * v[j].z + v[j].w * v[j].w); }
    const float rstd = 1.f / sqrtf(wave_sum(s2) * (1.f / DM) + LN_EPS);
    unsigned long long* o8 = (unsigned long long*)orow + lane;
#pragma unroll
    for (int j = 0; j < 4; ++j) { const f32x4 gg = ((const f32x4*)g)[lane + 64 * j], b4 = ((const f32x4*)bb)[lane + 64 * j];
        const f32x4 y = v[j] * rstd * gg + b4;
        o8[64 * j] = (unsigned long long)pk2(y.x, y.y) | ((unsigned long long)pk2(y.z, y.w) << 32); }
}
__device__ __forceinline__ void ln_row_bf16(bf16* hrow, const float* g, const float* bb, float* outrow, int lane) {
    float v[16]; float s = 0.f;
#pragma unroll
    for (int j = 0; j < 2; ++j) { const u32x4 w = *((const u32x4*)(hrow + 512 * j) + lane);
        v[8 * j + 0] = pg8::bflo(w.x); v[8 * j + 1] = pg8::bfhi(w.x); v[8 * j + 2] = pg8::bflo(w.y); v[8 * j + 3] = pg8::bfhi(w.y);
        v[8 * j + 4] = pg8::bflo(w.z); v[8 * j + 5] = pg8::bfhi(w.z); v[8 * j + 6] = pg8::bflo(w.w); v[8 * j + 7] = pg8::bfhi(w.w); }
#pragma unroll
    for (int i = 0; i < 16; ++i) s += v[i];
    const float mean = wave_sum(s) * (1.f / DM); float s2 = 0.f;
#pragma unroll
    for (int i = 0; i < 16; ++i) { v[i] -= mean; s2 += v[i] * v[i]; }
    const float rstd = 1.f / sqrtf(wave_sum(s2) * (1.f / DM) + LN_EPS);
#pragma unroll
    for (int j = 0; j < 2; ++j) {
        const int c0 = 512 * j + 8 * lane;
        const f32x4 g0 = *(const f32x4*)(g + c0), g1 = *(const f32x4*)(g + c0 + 4), b0 = *(const f32x4*)(bb + c0), b1 = *(const f32x4*)(bb + c0 + 4);
        f32x4 y0, y1;
#pragma unroll
        for (int q = 0; q < 4; ++q) { y0[q] = v[8 * j + q] * rstd * g0[q] + b0[q]; y1[q] = v[8 * j + 4 + q] * rstd * g1[q] + b1[q]; }
        if (outrow) { *(f32x4*)(outrow + c0) = y0; *(f32x4*)(outrow + c0 + 4) = y1; }
        else { u32x4 w; w.x = pk2(y0[0], y0[1]); w.y = pk2(y0[2], y0[3]); w.z = pk2(y1[0], y1[1]); w.w = pk2(y1[2], y1[3]); *((u32x4*)(hrow + c0)) = w; }
    }
}

template <int MODE>
__device__ __forceinline__ void ml_gates(const bf16* p, const float* ifb, int l, int row0, int tv0, int bc_idx, float* li, float* bc, float* wl, float* mt, float* wint,
                                         float* g_mloc, float* g_blast, const float* g_mprev, int tid) {
    if (tid < 256) { const int h = tid >> 6, t = tid & 63; const bool valid = t >= tv0;
        const float gi = bf2f(p[(size_t)(row0 + t) * DINP + PC_MI + h]) + ifb[l * 8 + h];
        const float gf = bf2f(p[(size_t)(row0 + t) * DINP + PC_MF + h]) + ifb[l * 8 + 4 + h];
        const float liv = valid ? gi : -1e30f; float cum = valid ? logsigmoidf_(gf) : 0.f;
#pragma unroll
        for (int o = 1; o < 64; o <<= 1) { const float v = __shfl_up(cum, o); if (t >= o) cum += v; }
        li[t * 4 + h] = liv; bc[t * 4 + h] = cum;
        if (MODE == 1) {
            const float blast = __builtin_bit_cast(float, __builtin_amdgcn_readlane(__builtin_bit_cast(int, cum), 63)); const float gl = blast - cum + liv; float mloc = gl;
#pragma unroll
            for (int o = 1; o < 64; o <<= 1) mloc = fmaxf(mloc, __shfl_xor(mloc, o));
            wl[t * 4 + h] = __expf(gl - mloc);
            if (t == 0) { g_mloc[bc_idx * 4 + h] = mloc; g_blast[bc_idx * 4 + h] = blast; }
        } else {
            const float mprev = (tv0 > 0) ? 0.f : g_mprev[bc_idx * 4 + h]; float rm = liv - cum;
#pragma unroll
            for (int o = 1; o < 64; o <<= 1) { const float v = __shfl_up(rm, o); if (t >= o) rm = fmaxf(rm, v); }
            const float mintra = cum + rm, minter = cum + mprev, m = fmaxf(mintra, minter);
            mt[t * 4 + h] = m; wint[t * 4 + h] = __expf(minter - m);
        }
    }
    __syncthreads();
}

constexpr int WT4_AUP = 8192, WT4_VUP = 16384, WT4_GUP = 24576, WT4_VDT = 40960, WT4_SZ = 49152;
template <int MODE>
__device__ __forceinline__ void rw_lora(const Args& a, const bf16* p, bf16* LO, float* Lf, int l_in, int c, int row0, int hrb, int tid_in) {
    typedef short bf16x8 __attribute__((ext_vector_type(8)));
    typedef unsigned u32x2_ __attribute__((ext_vector_type(2)));
    int l = __builtin_amdgcn_readfirstlane(l_in); asm volatile("" : "+s"(l));
    int tid = tid_in; asm volatile("" : "+v"(tid));
    bf16* VPb = (bf16*)Lf; bf16* TWb = VPb + 64 * 264; bf16* ADb = TWb + 64 * 40; bf16* SGb = ADb + 64 * 40; bf16* VDb = SGb + 64 * 72;
    const float* mu = a.in[8] + l * 896;
    const bf16* wt4 = (const bf16*)(a.ws + WS_WT4) + (size_t)l * WT4_SZ;
    {
        u32x4 cur[6], prv[6];
#pragma unroll
        for (int i = 0; i < 6; ++i) { const int idx = tid + NTHR * i, t = idx / 48, c8 = idx % 48; const bf16* src = p + (size_t)(row0 + t) * DINP + PC_RW + 512 + c8 * 8;
            cur[i] = *(const u32x4*)src; prv[i] = (u32x4){0u, 0u, 0u, 0u}; if (64 * c + t - 1 >= PADT) prv[i] = (t > 0) ? *(const u32x4*)(src - DINP) : *(const u32x4*)(p + (size_t)(hrb - 1) * DINP + PC_RW + 512 + c8 * 8); }
#pragma unroll
        for (int i = 0; i < 6; ++i) { const int idx = tid + NTHR * i, t = idx / 48, c8 = idx % 48, col = 512 + c8 * 8;
            const float cf[8] = {pg8::bflo(cur[i].x), pg8::bfhi(cur[i].x), pg8::bflo(cur[i].y), pg8::bfhi(cur[i].y), pg8::bflo(cur[i].z), pg8::bfhi(cur[i].z), pg8::bflo(cur[i].w), pg8::bfhi(cur[i].w)};
            const float pf[8] = {pg8::bflo(prv[i].x), pg8::bfhi(prv[i].x), pg8::bflo(prv[i].y), pg8::bfhi(prv[i].y), pg8::bflo(prv[i].z), pg8::bfhi(prv[i].z), pg8::bflo(prv[i].w), pg8::bfhi(prv[i].w)};
            const f32x4 m0 = *(const f32x4*)(mu + col), m1 = *(const f32x4*)(mu + col + 4);
            float pm[8];
#pragma unroll
            for (int q = 0; q < 4; ++q) { pm[q] = cf[q] + (pf[q] - cf[q]) * m0[q]; pm[4 + q] = cf[4 + q] + (pf[4 + q] - cf[4 + q]) * m1[q]; }
            bf16* dst;
            if (c8 < 32) { dst = VPb + t * 264 + c8 * 8; }
            else if (c8 < 36) { dst = TWb + t * 40 + (c8 - 32) * 8;
#pragma unroll
                for (int q = 0; q < 8; ++q) pm[q] = tanhf_(pm[q]); }
            else if (c8 < 40) { dst = ADb + t * 40 + (c8 - 36) * 8; }
            else { dst = SGb + t * 72 + (c8 - 40) * 8;
#pragma unroll
                for (int q = 0; q < 8; ++q) pm[q] = sigmoidf_(pm[q]); }
            u32x4 o; o.x = pk2(pm[0], pm[1]); o.y = pk2(pm[2], pm[3]); o.z = pk2(pm[4], pm[5]); o.w = pk2(pm[6], pm[7]);
            *(u32x4*)dst = o; }
    }
    __syncthreads();
    const int lane = tid & 63, wv_ = __builtin_amdgcn_readfirstlane(tid >> 6), r = lane & 15, g = lane >> 4;
    if (l > 0) {
        const int tt = wv_ & 3, jt = wv_ >> 2; f32x4 acc = {0.f, 0.f, 0.f, 0.f};
#pragma unroll
        for (int kk = 0; kk < 8; ++kk) { const bf16x8 fa = *(const bf16x8*)(wt4 + WT4_VDT + (16 * jt + r) * 256 + 32 * kk + 8 * g), fb = *(const bf16x8*)(VPb + (16 * tt + r) * 264 + 32 * kk + 8 * g);
            acc = __builtin_amdgcn_mfma_f32_16x16x32_bf16(fa, fb, acc, 0, 0, 0); }
        u32x2_ o; o.x = pk2(acc[0], acc[1]); o.y = pk2(acc[2], acc[3]);
        *(u32x2_*)(VDb + (16 * tt + r) * 40 + 16 * jt + 4 * g) = o;
        __syncthreads();
    }
    {
        const int ch0 = 32 * wv_;
#pragma unroll
        for (int ct = 0; ct < 2; ++ct) { const int chr = ch0 + 16 * ct + r;
            const bf16x8 wu = *(const bf16x8*)(wt4 + chr * 32 + 8 * g), au = *(const bf16x8*)(wt4 + WT4_AUP + chr * 32 + 8 * g), vu = *(const bf16x8*)(wt4 + WT4_VUP + chr * 32 + 8 * g);
            const bf16x8 gu0 = *(const bf16x8*)(wt4 + WT4_GUP + chr * 64 + 8 * g), gu1 = *(const bf16x8*)(wt4 + WT4_GUP + chr * 64 + 32 + 8 * g);
#pragma unroll
            for (int tt = 0; tt < 4; ++tt) { const int t = 16 * tt + r; const f32x4 z4 = {0.f, 0.f, 0.f, 0.f};
                const bf16x8 bt = *(const bf16x8*)(TWb + t * 40 + 8 * g), ba = *(const bf16x8*)(ADb + t * 40 + 8 * g), bg0 = *(const bf16x8*)(SGb + t * 72 + 8 * g), bg1 = *(const bf16x8*)(SGb + t * 72 + 32 + 8 * g);
                const f32x4 dW = __builtin_amdgcn_mfma_f32_16x16x32_bf16(wu, bt, z4, 0, 0, 0), dA = __builtin_amdgcn_mfma_f32_16x16x32_bf16(au, ba, z4, 0, 0, 0);
                f32x4 dV = z4; if (l > 0) { const bf16x8 bv = *(const bf16x8*)(VDb + t * 40 + 8 * g); dV = __builtin_amdgcn_mfma_f32_16x16x32_bf16(vu, bv, z4, 0, 0, 0); }
                f32x4 dG = __builtin_amdgcn_mfma_f32_16x16x32_bf16(gu0, bg0, z4, 0, 0, 0); dG = __builtin_amdgcn_mfma_f32_16x16x32_bf16(gu1, bg1, dG, 0, 0, 0);
                u32x4 o0, o1; o0.x = pk2(dW[0], dA[0]); o0.y = pk2(dV[0], dG[0]); o0.z = pk2(dW[1], dA[1]); o0.w = pk2(dV[1], dG[1]);
                o1.x = pk2(dW[2], dA[2]); o1.y = pk2(dV[2], dG[2]); o1.z = pk2(dW[3], dA[3]); o1.w = pk2(dV[3], dG[3]);
                u32x4* dst = (u32x4*)(LO + ((size_t)t * 256 + ch0 + 16 * ct + 4 * g) * 4); dst[0] = o0; dst[1] = o1; } }
    }
    __syncthreads();
}

struct RwLds { float *R, *Dd, *Kp, *Vp, *KK, *Bv, *G, *bsum, *raw; };
template <int MODE>
__device__ __forceinline__ void rw_prep(const Args& a, const bf16* p, bf16* vfirst, const bf16* LO, const RwLds& L, int l, int c, int row0, int hrb, int ts, int tid) {
    const float* mu = a.in[8] + l * 896;
    const int ch = tid & 255, th = tid >> 8, lane = tid & 63, head = ch >> 6;
    typedef unsigned u32x2 __attribute__((ext_vector_type(2)));
    u32x2 lo[4]; float vf[4] = {0.f, 0.f, 0.f, 0.f};
    { u32x4 v[2];
#pragma unroll
      for (int i = 0; i < 2; ++i) { const int idx = tid + NTHR * i, rr = idx / 96, c8 = idx % 96, tl = ts - 1 + rr; const bool ok = (idx < 9 * 96) && (64 * c + tl >= PADT);
          v[i] = (u32x4){0u, 0u, 0u, 0u}; if (ok) v[i] = *(const u32x4*)(p + (size_t)(tl < 0 ? hrb + tl : row0 + tl) * DINP + PC_RW + c8 * 8); }
#pragma unroll
      for (int i = 0; i < 4; ++i) { lo[i] = *(const u32x2*)(LO + ((size_t)(ts + th * 4 + i) * 256 + ch) * 4); if (l > 0) vf[i] = bf2f(vfirst[(size_t)(row0 + ts + th * 4 + i) * 256 + ch]); }
#pragma unroll
      for (int i = 0; i < 2; ++i) { const int idx = tid + NTHR * i; if (idx < 9 * 96) {
          const f32x4 f0 = {pg8::bflo(v[i].x), pg8::bfhi(v[i].x), pg8::bflo(v[i].y), pg8::bfhi(v[i].y)}, f1 = {pg8::bflo(v[i].z), pg8::bfhi(v[i].z), pg8::bflo(v[i].w), pg8::bfhi(v[i].w)};
          *(f32x4*)&L.raw[idx * 8] = f0; *(f32x4*)&L.raw[idx * 8 + 4] = f1; } } }
    __syncthreads();
    const float w0 = a.in[9][l * 256 + ch], a0 = a.in[11][l * 256 + ch], kkc = a.in[14][l * 256 + ch], kac = a.in[15][l * 256 + ch], rkc = a.in[16][l * 256 + ch];
    const float v0 = (l > 0) ? a.in[19][(l - 1) * 256 + ch] : 0.f;
    const float mur = mu[ch], muk = mu[256 + ch], muv = mu[512 + ch];
#pragma unroll
    for (int i = 0; i < 4; ++i) { const int t = th * 4 + i, tl = ts + t; const size_t row = (size_t)(row0 + tl);
        const float rc = L.raw[(t + 1) * 768 + ch], rp = L.raw[t * 768 + ch], kc = L.raw[(t + 1) * 768 + 256 + ch], kp_ = L.raw[t * 768 + 256 + ch], vc = L.raw[(t + 1) * 768 + 512 + ch], vp_ = L.raw[t * 768 + 512 + ch];
        const float r = rc + (rp - rc) * mur, k = kc + (kp_ - kc) * muk; float v = vc + (vp_ - vc) * muv;
        const float aw = pg8::bflo(lo[i].x), aa = pg8::bfhi(lo[i].x), av = pg8::bflo(lo[i].y), ag = pg8::bfhi(lo[i].y);
        const float w = -softplusf_(-(w0 + aw)) - 0.5f; const float d = __expf(-__expf(w));
        const float av_ = sigmoidf_(a0 + aa);
        if (l == 0) { if (MODE == 1) vfirst[row * 256 + ch] = (bf16)f2bf(v); }
        else { v = v + (vf[i] - v) * sigmoidf_(v0 + av); }
        float kk = k * kkc; const float ss = wave_sum(kk * kk); kk = kk * (1.f / sqrtf(ss + 1e-12f));
        const float kp = k * (1.f + (av_ - 1.f) * kac);
        L.R[t * 256 + ch] = r; L.Dd[t * 256 + ch] = d; L.Kp[t * 256 + ch] = kp; L.Vp[t * 256 + ch] = v; L.KK[t * 256 + ch] = kk; L.Bv[t * 256 + ch] = kk * av_;
        if (MODE == 3) { L.G[t * 256 + ch] = ag; const float bs = wave_sum(r * kp * rkc); if (lane == 0) L.bsum[t * 4 + head] = bs; }
    }
    __syncthreads();
}

constexpr int WY_RS = 264  , WY_TS = 40  , WY_RH = 20  ;
constexpr int WY_AROW = 0, WY_BROW = 8448, WY_KROW = 16896, WY_PROW = 25344, WY_BKT = 33792, WY_UV = 54272, WY_VP = 74752, WY_G = 91136, WY_G16 = 107520, WY_BSUM = 108544, WY_SCR = 108800, WY_WSCR = 8704, WY_UVB = 20480;
static_assert(WY_SCR + 4 * WY_WSCR <= 147392, "WY LDS map");
typedef short wy_bf16x8 __attribute__((ext_vector_type(8)));
typedef unsigned wy_u32x2 __attribute__((ext_vector_type(2)));
template <int MODE>
__device__ __forceinline__ void wy_prep(const Args& a, const bf16* p, bf16* vfirst, const bf16* LO, unsigned char* lb, int l, int c, int row0, int hrb, int ts, int tid_in) {
    int tid = tid_in; asm volatile("" : "+v"(tid));
    const float* mu = a.in[8] + l * 896;
    const int ch = tid & 255, th = tid >> 8, lane = tid & 63, head = ch >> 6;
    bf16* rawb = (bf16*)(lb + WY_SCR);
    wy_u32x2 lo[8]; float vf[8];
    { u32x4 v[4];
#pragma unroll
      for (int i = 0; i < 4; ++i) { const int idx = tid + NTHR * i, rr = idx / 96, c8 = idx % 96, tl = ts - 1 + rr; const bool ok = (idx < 17 * 96) && (64 * c + tl >= PADT);
          v[i] = (u32x4){0u, 0u, 0u, 0u}; if (ok) v[i] = *(const u32x4*)(p + (size_t)(tl < 0 ? hrb + tl : row0 + tl) * DINP + PC_RW + c8 * 8); }
#pragma unroll
      for (int i = 0; i < 8; ++i) { lo[i] = *(const wy_u32x2*)(LO + ((size_t)(ts + th * 8 + i) * 256 + ch) * 4); vf[i] = (l > 0) ? bf2f(vfirst[(size_t)(row0 + ts + th * 8 + i) * 256 + ch]) : 0.f; }
#pragma unroll
      for (int i = 0; i < 4; ++i) { const int idx = tid + NTHR * i; if (idx < 17 * 96) *(u32x4*)(rawb + idx * 8) = v[i]; } }
    __syncthreads();
    const float w0 = a.in[9][l * 256 + ch], a0 = a.in[11][l * 256 + ch], kkc = a.in[14][l * 256 + ch], kac = a.in[15][l * 256 + ch], rkc = a.in[16][l * 256 + ch];
    const float v0 = (l > 0) ? a.in[19][(l - 1) * 256 + ch] : 0.f;
    const float mur = mu[ch], muk = mu[256 + ch], muv = mu[512 + ch];
    float* Vp = (float*)(lb + WY_VP); float* Gt = (float*)(lb + WY_G); float* bsum = (float*)(lb + WY_BSUM); float* g16 = (float*)(lb + WY_G16);
    bf16* UV = (bf16*)(lb + WY_UV);
    bf16* Ar = (bf16*)(lb + WY_AROW); bf16* Br = (bf16*)(lb + WY_BROW); bf16* Kr = (bf16*)(lb + WY_KROW); bf16* Pr = (bf16*)(lb + WY_PROW); bf16* BKT = (bf16*)(lb + WY_BKT);
    float cum = 0.f;
    if (th == 1) {
#pragma unroll
        for (int i = 0; i < 8; ++i) { const wy_u32x2 l0 = *(const wy_u32x2*)(LO + ((size_t)(ts + i) * 256 + ch) * 4); cum -= __expf(-softplusf_(-(w0 + pg8::bflo(l0.x))) - 0.5f); } }
    float eprev = __expf(cum);
    unsigned pkb[4], pkk[4], pkv[4];
#pragma unroll
    for (int i = 0; i < 8; ++i) { const int t = th * 8 + i; const size_t row = (size_t)(row0 + ts + t);
        const float rc = bf2f(rawb[(t + 1) * 768 + ch]), rp = bf2f(rawb[t * 768 + ch]), kc = bf2f(rawb[(t + 1) * 768 + 256 + ch]), kp_ = bf2f(rawb[t * 768 + 256 + ch]), vc = bf2f(rawb[(t + 1) * 768 + 512 + ch]), vp_ = bf2f(rawb[t * 768 + 512 + ch]);
        const float r = rc + (rp - rc) * mur, k = kc + (kp_ - kc) * muk; float v = vc + (vp_ - vc) * muv;
        const float aw = pg8::bflo(lo[i].x), aa = pg8::bfhi(lo[i].x), av = pg8::bflo(lo[i].y), ag = pg8::bfhi(lo[i].y);
        const float w = -softplusf_(-(w0 + aw)) - 0.5f; const float lgd = -__expf(w);
        const float av_ = sigmoidf_(a0 + aa);
        if (l == 0) { if (MODE == 1) vfirst[row * 256 + ch] = (bf16)f2bf(v); }
        else { v = v + (vf[i] - v) * sigmoidf_(v0 + av); }
        float kk = k * kkc; const float ss = wave_sum(kk * kk); kk = kk * frsq_(ss + 1e-12f);
        const float kp = k * (1.f + (av_ - 1.f) * kac);
        cum += lgd; const float ep = __expf(cum), en = frcp_(ep);
        const unsigned al = f2bf(kk * eprev), be = f2bf(kk * av_ * en), ka = f2bf(kp * en), rh = f2bf(r * ep); eprev = ep;
        Ar[t * WY_RS + ch] = (bf16)al; Br[t * WY_RS + ch] = (bf16)be; Kr[t * WY_RS + ch] = (bf16)ka; if (MODE == 3) Pr[t * WY_RS + ch] = (bf16)rh;
        { const unsigned nb = be ^ 0x8000u, vb_ = f2bf(v); if (i & 1) { pkb[i >> 1] |= nb << 16; pkk[i >> 1] |= ka << 16; pkv[i >> 1] |= vb_ << 16; } else { pkb[i >> 1] = nb; pkk[i >> 1] = ka; pkv[i >> 1] = vb_; } }
        if (MODE == 3) Vp[t * 256 + ch] = v;
        if (MODE == 3) { Gt[t * 256 + ch] = ag; const float bs = wave_sum(r * kp * rkc); if (lane == 0) bsum[t * 4 + head] = bs; }
    }
    { u32x4 w; w.x = pkb[0]; w.y = pkb[1]; w.z = pkb[2]; w.w = pkb[3]; *(u32x4*)(BKT + ch * WY_TS + th * 8) = w;
      w.x = pkk[0]; w.y = pkk[1]; w.z = pkk[2]; w.w = pkk[3]; *(u32x4*)(BKT + ch * WY_TS + 16 + th * 8) = w;
      w.x = pkv[0]; w.y = pkv[1]; w.z = pkv[2]; w.w = pkv[3]; *(u32x4*)(UV + ch * WY_TS + 16 + th * 8) = w; }
    if (th == 1) g16[ch] = __expf(cum);
    __syncthreads();
}

template <int MODE>
__device__ __forceinline__ void wy_block(f32x4 (&acc)[4][4], unsigned char* lb, int h, int lane_in, bf16* UV  , unsigned char* ws_  , float* Rh  , bf16* mixrow, const float* gng, const float* gnb) {
    int lane = lane_in; asm volatile("" : "+v"(lane));
    const int r = lane & 15, g = lane >> 4;
    const bf16* Ar = (const bf16*)(lb + WY_AROW) + h * 64; const bf16* Br = (const bf16*)(lb + WY_BROW) + h * 64; const bf16* Kr = (const bf16*)(lb + WY_KROW) + h * 64; const bf16* Pr = (const bf16*)(lb + WY_PROW) + h * 64;
    const bf16* BKT = (const bf16*)(lb + WY_BKT) + (size_t)h * 64 * WY_TS;
    float* NmT = (float*)ws_; bf16* MTz = (bf16*)(ws_ + 1024); bf16* NMT = (bf16*)(ws_ + 2304);
#define WY_FENCE() asm volatile("s_waitcnt lgkmcnt(0)" ::: "memory")
    wy_bf16x8 Bs[2][4];
#pragma unroll
    for (int kk = 0; kk < 2; ++kk)
#pragma unroll
        for (int rt = 0; rt < 4; ++rt) { u32x4 w; const f32x4 x = acc[2 * kk][rt], y = acc[2 * kk + 1][rt];
            w.x = pg8::cvt_pk_bf16(x[0], x[1]); w.y = pg8::cvt_pk_bf16(x[2], x[3]); w.z = pg8::cvt_pk_bf16(y[0], y[1]); w.w = pg8::cvt_pk_bf16(y[2], y[3]); Bs[kk][rt] = __builtin_bit_cast(wy_bf16x8, w); }
    f32x4 dN = {0.f, 0.f, 0.f, 0.f}, dM = dN, dNp = dN, dMp = dN;
#pragma unroll
    for (int kk = 0; kk < 2; ++kk) { const int o = r * WY_RS + 32 * kk + 8 * g;
        const wy_bf16x8 fb = *(const wy_bf16x8*)(Br + o), fk = *(const wy_bf16x8*)(Kr + o), fa = *(const wy_bf16x8*)(Ar + o), fp = *(const wy_bf16x8*)(Pr + o);
        dN = __builtin_amdgcn_mfma_f32_16x16x32_bf16(fb, fa, dN, 0, 0, 0); dM = __builtin_amdgcn_mfma_f32_16x16x32_bf16(fk, fa, dM, 0, 0, 0);
        if (MODE == 3) { dNp = __builtin_amdgcn_mfma_f32_16x16x32_bf16(fb, fp, dNp, 0, 0, 0); dMp = __builtin_amdgcn_mfma_f32_16x16x32_bf16(fk, fp, dMp, 0, 0, 0); } }
    { unsigned long long* z = (unsigned long long*)(MTz + (lane >> 2) * WY_TS + (lane & 3) * 4); *z = 0ull; }
#pragma unroll
    for (int i = 0; i < 4; ++i) { const int s = 4 * g + i, t = r;
        NmT[t * 16 + s] = (s < t) ? dN[i] : 0.f;
        MTz[t * WY_TS + 16 + s] = (bf16)f2bf((s < t) ? dM[i] : 0.f);
        if (MODE == 3) { NMT[t * WY_TS + s] = (bf16)f2bf((s <= t) ? -dNp[i] : 0.f); NMT[t * WY_TS + 16 + s] = (bf16)f2bf((s <= t) ? dMp[i] : 0.f); } }
    f32x4 zt[4], yt[4];
#pragma unroll
    for (int rt = 0; rt < 4; ++rt) { zt[rt] = (f32x4){0.f, 0.f, 0.f, 0.f}; yt[rt] = (f32x4){0.f, 0.f, 0.f, 0.f}; }
#pragma unroll
    for (int kk = 0; kk < 2; ++kk) { const int o = r * WY_RS + 32 * kk + 4 * g;
        const wy_u32x2 a0 = *(const wy_u32x2*)(Ar + o), a1 = *(const wy_u32x2*)(Ar + o + 16), p0 = *(const wy_u32x2*)(Pr + o), p1 = *(const wy_u32x2*)(Pr + o + 16);
        const u32x4 aw = {a0.x, a0.y, a1.x, a1.y}, pw = {p0.x, p0.y, p1.x, p1.y}; const wy_bf16x8 fa = __builtin_bit_cast(wy_bf16x8, aw), fp = __builtin_bit_cast(wy_bf16x8, pw);
#pragma unroll
        for (int rt = 0; rt < 4; ++rt) { zt[rt] = __builtin_amdgcn_mfma_f32_16x16x32_bf16(fa, Bs[kk][rt], zt[rt], 0, 0, 0); if (MODE == 3) yt[rt] = __builtin_amdgcn_mfma_f32_16x16x32_bf16(fp, Bs[kk][rt], yt[rt], 0, 0, 0); } }
    WY_FENCE();
    { const wy_bf16x8 am = *(const wy_bf16x8*)(MTz + r * WY_TS + 8 * g);
#pragma unroll
      for (int rt = 0; rt < 4; ++rt) { const wy_bf16x8 buv = *(const wy_bf16x8*)(UV + (16 * rt + r) * WY_TS + 8 * g); zt[rt] = __builtin_amdgcn_mfma_f32_16x16x32_bf16(am, buv, zt[rt], 0, 0, 0); } }
#pragma unroll
    for (int rt = 0; rt < 4; ++rt) *(f32x4*)(Rh + (16 * rt + r) * WY_RH + 4 * g) = zt[rt];
    WY_FENCE();
    { float u[16];
#pragma unroll
      for (int q = 0; q < 4; ++q) { const f32x4 x = *(const f32x4*)(Rh + lane * WY_RH + 4 * q); u[4 * q] = x.x; u[4 * q + 1] = x.y; u[4 * q + 2] = x.z; u[4 * q + 3] = x.w; }
#pragma unroll
      for (int t = 1; t < 16; ++t) { float x = u[t];
#pragma unroll
          for (int s4 = 0; s4 < (t + 3) / 4; ++s4) { const f32x4 n = *(const f32x4*)(NmT + t * 16 + 4 * s4);
#pragma unroll
              for (int q = 0; q < 4; ++q) if (4 * s4 + q < t) x -= u[4 * s4 + q] * n[q]; }
          u[t] = x; asm volatile("" ::: "memory"); }
      u32x4 o0, o1; o0.x = pg8::cvt_pk_bf16(u[0], u[1]); o0.y = pg8::cvt_pk_bf16(u[2], u[3]); o0.z = pg8::cvt_pk_bf16(u[4], u[5]); o0.w = pg8::cvt_pk_bf16(u[6], u[7]);
      o1.x = pg8::cvt_pk_bf16(u[8], u[9]); o1.y = pg8::cvt_pk_bf16(u[10], u[11]); o1.z = pg8::cvt_pk_bf16(u[12], u[13]); o1.w = pg8::cvt_pk_bf16(u[14], u[15]);
      *(u32x4*)(UV + lane * WY_TS) = o0; *(u32x4*)(UV + lane * WY_TS + 8) = o1; }
    WY_FENCE();
    wy_bf16x8 buv[4];
#pragma unroll
    for (int rt = 0; rt < 4; ++rt) buv[rt] = *(const wy_bf16x8*)(UV + (16 * rt + r) * WY_TS + 8 * g);
    if (MODE == 3) { const wy_bf16x8 an = *(const wy_bf16x8*)(NMT + r * WY_TS + 8 * g);
#pragma unroll
        for (int rt = 0; rt < 4; ++rt) yt[rt] = __builtin_amdgcn_mfma_f32_16x16x32_bf16(an, buv[rt], yt[rt], 0, 0, 0); }
    const float* g16 = (const float*)(lb + WY_G16) + h * 64;
#pragma unroll
    for (int jt = 0; jt < 4; ++jt) { const wy_bf16x8 ab = *(const wy_bf16x8*)(BKT + (16 * jt + r) * WY_TS + 8 * g); const f32x4 gm = *(const f32x4*)(g16 + 16 * jt + 4 * g);
#pragma unroll
        for (int rt = 0; rt < 4; ++rt) { f32x4 n = __builtin_amdgcn_mfma_f32_16x16x32_bf16(ab, buv[rt], acc[jt][rt], 0, 0, 0); acc[jt][rt] = n * gm; } }
    if (MODE == 3) {
        const float* Vp = (const float*)(lb + WY_VP) + h * 64; const float* Gt = (const float*)(lb + WY_G) + h * 64; const float* bsum = (const float*)(lb + WY_BSUM);
        float gg[4], gb[4];
#pragma unroll
        for (int rt = 0; rt < 4; ++rt) { gg[rt] = gng[16 * rt + r]; gb[rt] = gnb[16 * rt + r]; }
#pragma unroll
        for (int i = 0; i < 4; ++i) { const int t = 4 * g + i;
            float s1 = (yt[0][i] + yt[1][i]) + (yt[2][i] + yt[3][i]);
            s1 = row16_sum(s1);
            const float mean = s1 * (1.f / 64.f); float s2 = 0.f;
#pragma unroll
            for (int rt = 0; rt < 4; ++rt) { const float dlt = yt[rt][i] - mean; s2 += dlt * dlt; }
            s2 = row16_sum(s2);
            const float rstd = 1.f / sqrtf(s2 * (1.f / 64.f) + GN_EPS); const float bs = bsum[t * 4 + h];
#pragma unroll
            for (int rt = 0; rt < 4; ++rt) { const int row = 16 * rt + r; const float yn = (yt[rt][i] - mean) * rstd * gg[rt] + gb[rt];
                const float o = (yn + bs * Vp[t * 256 + row]) * Gt[t * 256 + row];
                mixrow[(size_t)t * DM + row] = (bf16)f2bf(o); } }
    }
#undef WY_FENCE
}

template <int EPI>
__device__ __forceinline__ void side_gemm(const bf16* A, const bf16* Bt, int K, int N, bf16* O, int ldo, float alpha, unsigned char* lds_, int bid, int G) {
    typedef short bf16x8 __attribute__((ext_vector_type(8)));
    int tid = threadIdx.x; asm volatile("" : "+v"(tid)); const int lane = tid & 63, wv_ = __builtin_amdgcn_readfirstlane(tid >> 6), r = lane & 15, g = lane >> 4;
    f32x4* red = (f32x4*)lds_;
    for (int nt = bid; nt < N / 16; nt += G) {
        f32x4 acc[8];
#pragma unroll
        for (int mt = 0; mt < 8; ++mt) acc[mt] = (f32x4){0.f, 0.f, 0.f, 0.f};
        const int kw = K / 8; const bf16* bp = Bt + (size_t)(16 * nt + r) * K + wv_ * kw + 8 * g; const bf16* ap = A + (size_t)r * K + wv_ * kw + 8 * g;
#pragma unroll 2
        for (int ks = 0; ks < kw / 32; ++ks) { const bf16x8 fb = *(const bf16x8*)(bp + 32 * ks);
#pragma unroll
            for (int mt = 0; mt < 8; ++mt) { const bf16x8 fa = *(const bf16x8*)(ap + (size_t)(16 * mt) * K + 32 * ks); acc[mt] = __builtin_amdgcn_mfma_f32_16x16x32_bf16(fa, fb, acc[mt], 0, 0, 0); } }
#pragma unroll
        for (int mt = 0; mt < 8; ++mt) red[(wv_ * 8 + mt) * 64 + lane] = acc[mt];
        __syncthreads();
        { const int mt = tid >> 6; f32x4 s = red[mt * 64 + lane];
#pragma unroll
          for (int w = 1; w < 8; ++w) s += red[(w * 8 + mt) * 64 + lane];
          const int n = 16 * nt + r;
#pragma unroll
          for (int i = 0; i < 4; ++i) { const int row = 16 * mt + 4 * g + i; bf16* op = O + (size_t)row * ldo + n; float v = s[i];
              if (EPI == 1) v = alpha * bf2f(*op) + v;
              if (EPI == 2) { v = v > 0.f ? v : 0.f; v = v * v; }
              *op = (bf16)f2bf(v); } }
        __syncthreads();
    }
}

#define XB_TMO      128
#define XB_XCNT(j)  (256  + 64 * (j))
#define XB_XSUB(j)  (1280 + 64 * (j))
#define XB_XGEN(j)  (2304 + 64 * (j))
#define XB_TOP      3328
#define XB_TOPGEN   3392
#define XCD_BAR_WORDS 3456
#define XB_SPIN_CAP (1u << 18)

__device__ __forceinline__ unsigned xb_ld(unsigned* p)              { return __hip_atomic_load(p, __ATOMIC_RELAXED, __HIP_MEMORY_SCOPE_AGENT); }
__device__ __forceinline__ unsigned xb_add(unsigned* p, unsigned v) { return __hip_atomic_fetch_add(p, v, __ATOMIC_RELAXED, __HIP_MEMORY_SCOPE_AGENT); }
__device__ __forceinline__ unsigned xb_xcc_id() { return (unsigned)__builtin_amdgcn_s_getreg((3 << 11) | 20) & 0xFu; }
#define XB_SPIN(cond, bar) do { unsigned _sp = 0; while (cond) { __builtin_amdgcn_s_sleep(1); \
    if ((++_sp & 255u) == 0u) { if (xb_ld(&(bar)[XB_TMO])) break; if (_sp > XB_SPIN_CAP) { atomicAdd(&(bar)[XB_TMO], 1u); break; } } } } while (0)

struct XcdBarrier {
    unsigned* bar; unsigned x;
    volatile PG8_LAS unsigned* st;
};

__device__ __forceinline__ XcdBarrier xcd_barrier_post(unsigned* bar, volatile PG8_LAS unsigned* st) {
    XcdBarrier b; b.bar = bar; b.x = xb_xcc_id(); b.st = st;
    if (threadIdx.x == 0) (void)xb_add(&bar[XB_XCNT(b.x)], 1u);
    return b;
}
__device__ __forceinline__ void xcd_barrier_complete(unsigned* bar, unsigned x, unsigned& nloc, unsigned& nx) {
    const unsigned G = gridDim.x * gridDim.y * gridDim.z;
    unsigned sum, cnt, mine, sp = 0u;
    for (;;) {
        sum = 0u; cnt = 0u; mine = 0u;
#pragma unroll
        for (unsigned j = 0; j < 16; ++j) { const unsigned c = xb_ld(&bar[XB_XCNT(j)]); sum += c; cnt += (c > 0u) ? 1u : 0u; mine = (j == x) ? c : mine; }
        if (sum == G) break;
        __builtin_amdgcn_s_sleep(1);
        if ((++sp & 255u) == 0u) { if (xb_ld(&bar[XB_TMO])) break; if (sp > XB_SPIN_CAP) { atomicAdd(&bar[XB_TMO], 1u); break; } }
    }
    nloc = mine > 0u ? mine : 1u; nx = cnt > 0u ? cnt : 1u;
}

__device__ __forceinline__ void xcd_barrier(const XcdBarrier& b) {
    asm volatile("s_waitcnt vmcnt(0)" ::: "memory");
    __syncthreads();
    if (threadIdx.x == 0) {
        unsigned* bar = b.bar;
        __builtin_amdgcn_s_waitcnt(0);
        unsigned nloc = b.st[0], nx = b.st[1];
        if (nloc == 0u) { xcd_barrier_complete(bar, b.x, nloc, nx); b.st[0] = nloc; b.st[1] = nx; }
        const unsigned old = xb_add(&bar[XB_XSUB(b.x)], 1u);
        const unsigned gen = old / nloc;
        if (old + 1u == (gen + 1u) * nloc) {
            __builtin_amdgcn_fence(__ATOMIC_RELEASE, "agent");
            asm volatile("s_waitcnt vmcnt(0)" ::: "memory");
            const unsigned og = xb_add(&bar[XB_TOP], 1u);
            const unsigned tg = og / nx;
            if (og + 1u == (tg + 1u) * nx) xb_add(&bar[XB_TOPGEN], 1u);
            else XB_SPIN(xb_ld(&bar[XB_TOPGEN]) == tg, bar);
            __builtin_amdgcn_fence(__ATOMIC_ACQUIRE, "agent");
            xb_add(&bar[XB_XGEN(b.x)], 1u);
            asm volatile("s_waitcnt vmcnt(0)" ::: "memory");
        } else {
            XB_SPIN(xb_ld(&bar[XB_XGEN(b.x)]) == gen, bar);
            __builtin_amdgcn_fence(__ATOMIC_ACQUIRE, "agent");
            asm volatile("s_waitcnt vmcnt(0)" ::: "memory");
        }
    }
    __syncthreads();
}

__global__ void __launch_bounds__(NTHR, 2) hybrid_fwd(Args a0) {
    extern __shared__ __attribute__((aligned(16))) unsigned char lds[];
    cg::grid_group grid = cg::this_grid();
    const int G = gridDim.x, bid = blockIdx.x, NGW = G * 8;
    unsigned char* const ws_g = a0.ws; unsigned char* ws = ws_g;
#define hb ((bf16*)(ws + WS_HB))
#define pbuf ((bf16*)(ws + WS_U + U_P))
#define mix ((bf16*)(ws + WS_U + U_MIX))
#define acg ((bf16*)(ws + WS_U + U_ACG))
#define ffh ((bf16*)(ws + WS_U))
#define lruA ((float*)(ws + WS_LRUA))
#define lruH ((float*)(ws + WS_LRUH))
#define lruS ((float*)(ws + WS_LRUS))
#define mlN ((float*)(ws + WS_MLN))
#define mlM ((float*)(ws + WS_MLM))
#define mlB ((float*)(ws + WS_MLB))
#define mlP ((float*)(ws + WS_MLP))
    unsigned char* const dsc_g = (unsigned char*)a0.out; unsigned char* dsc = dsc_g; (void)dsc;
#define vfirst ((bf16*)(dsc + DO_VF))
#define rwP ((float*)(dsc + DO_RWP))
#define rwS ((float*)(dsc + DO_RWS))
#define mlC ((float*)(dsc + DO_MLC))
    float* L = (float*)lds;
    volatile PG8_LAS unsigned* xst = (volatile PG8_LAS unsigned*)((PG8_LAS unsigned char*)lds + LDS_BYTES - 64);
    if (threadIdx.x == 0) { xst[0] = 0u; xst[1] = 0u; }
    __syncthreads();
    (void)xcd_barrier_post((unsigned*)(a0.ws + WS_BAR), xst);
#define GBAR() do { XcdBarrier b_; b_.bar = (unsigned*)(a0.ws + WS_BAR); b_.x = xb_xcc_id(); b_.st = (volatile PG8_LAS unsigned*)((PG8_LAS unsigned char*)lds + LDS_BYTES - 64); xcd_barrier(b_); } while (0)
    Args a;
    { const float* par = (const float*)(a0.ws + WS_PAR);
      constexpr int PSZ[38] = {0, 0, 0, 0, 0, 0, 65536, 1024, 3584, 1024, 32768, 1024, 32768, 65536, 1024, 1024, 1024, 1024, 1024, 768, 24576, 24576, 4096, 1024, 65536, 1024, 65536, 1024, 1024, 32, 1024, 1024, 4096, 4096, 4096, 4096, 0, 0}; constexpr int POFF[38] = {0, 0, 0, 0, 0, 0, 0, 65536, 66560, 70144, 71168, 103936, 104960, 137728, 203264, 204288, 205312, 206336, 207360, 208384, 209152, 233728, 258304, 262400, 263424, 328960, 329984, 395520, 396544, 397568, 397600, 398624, 399648, 403744, 407840, 411936, 0, 0};
#pragma unroll
      for (int i = 0; i < 38; ++i) a.in[i] = (PSZ[i] > 0) ? par + POFF[i] : a0.in[i];
      a.out = a0.out; a.ws = a0.ws;
      { bf16* wt3 = (bf16*)(a0.ws + WS_WT3);
        for (int e = blockIdx.x * NTHR + threadIdx.x; e < DEPTH * 3 * 4 * 4096; e += gridDim.x * NTHR) { const int cc = e & 63, n = (e >> 6) & 63, g = (e >> 12) & 3, lm = e >> 14, m = lm % 3, l = lm / 3;
            const float* src = (m == 0) ? a0.in[6] : (m == 1) ? a0.in[24] : a0.in[26];
            wt3[e] = (bf16)f2bf(src[(size_t)((l * 4 + g) * 64 + cc) * 64 + n]); } }
      { bf16* wt4 = (bf16*)(a0.ws + WS_WT4);
        for (int e = blockIdx.x * NTHR + threadIdx.x; e < DEPTH * 49152; e += gridDim.x * NTHR) { const int l = e / 49152, o = e % 49152; float v = 0.f;
            if (o < 8192) { const int ch = o >> 5, j = o & 31; v = a0.in[10][((size_t)l * 32 + j) * 256 + ch]; }
            else if (o < 16384) { const int q = o - 8192, ch = q >> 5, j = q & 31; v = a0.in[12][((size_t)l * 32 + j) * 256 + ch]; }
            else if (o < 24576) { const int q = o - 16384, ch = q >> 5, j = q & 31; if (l > 0) v = a0.in[21][((size_t)(l - 1) * 32 + j) * 256 + ch]; }
            else if (o < 40960) { const int q = o - 24576, ch = q >> 6, j = q & 63; v = a0.in[13][((size_t)l * 64 + j) * 256 + ch]; }
            else { const int q = o - 40960, j = q >> 8, cc = q & 255; if (l > 0) v = a0.in[20][((size_t)(l - 1) * 256 + cc) * 32 + j]; }
            wt4[e] = (bf16)f2bf(v); } }
      float* pw_ = (float*)(a0.ws + WS_PAR);
#pragma unroll 1
      for (int i = 0; i < 38; ++i) { const int n = PSZ[i]; if (n > 0) { const float* src = a0.in[i]; for (int e = blockIdx.x * NTHR + threadIdx.x; e < n; e += gridDim.x * NTHR) pw_[POFF[i] + e] = src[e]; } } }

    {
        int tid = threadIdx.x; asm volatile("" : "+v"(tid)); unsigned char* ws = ws_g; asm volatile("" : "+s"(ws)); unsigned char* dsc = dsc_g; asm volatile("" : "+s"(dsc)); (void)ws; (void)dsc; const int lane = tid & 63, wave = __builtin_amdgcn_readfirstlane(tid >> 6); const int gw = bid * 8 + wave; (void)lane; (void)gw;
        float* scr = L + wave * (64 * 33);
        constexpr int I_IN = (DM / 64) * (DINP / 32), I_OUT = (DM / 64) * (DM / 32), I_1 = (DM / 64) * (FF / 32), I_2 = (FF / 64) * (DM / 32), I_L = I_IN + I_OUT + I_1 + I_2;
        for (int it = gw; it < DEPTH * I_L; it += NGW) {
            const int l = it / I_L; int r = it % I_L; unsigned char* wl = ws + WS_W + (size_t)l * LW_SZ;
            if (r < I_IN) { transpose_item(a.in[4] + (size_t)l * DM * DIN, DM, DIN, DINP, (bf16*)(wl + LW_IN), scr, r, lane); continue; } r -= I_IN;
            if (r < I_OUT) { transpose_item(a.in[5] + (size_t)l * DM * DM, DM, DM, DM, (bf16*)(wl + LW_OUT), scr, r, lane); continue; } r -= I_OUT;
            if (r < I_1) { transpose_item(a.in[36] + (size_t)l * DM * FF, DM, FF, FF, (bf16*)(wl + LW_1), scr, r, lane); continue; } r -= I_1;
            transpose_item(a.in[37] + (size_t)l * FF * DM, FF, DM, DM, (bf16*)(wl + LW_2), scr, r, lane);
        }
        for (int m = gw; m < MP; m += NGW) {
            bf16* orow = hb + (size_t)m * DM; const int tp = (m - MMAIN) & 63;
            if (m >= MMAIN + 128 || (m >= MMAIN && tp < PADT)) { u32x4 z = {0u, 0u, 0u, 0u}; ((u32x4*)orow)[lane] = z; ((u32x4*)orow)[lane + 64] = z; }
            else { const float* src = (m >= MMAIN) ? a.in[1] + (size_t)(tp - PADT) * DM : a.in[0] + (size_t)m * DM;
                ln_row_f32_to_bf16(src, a.in[2], a.in[3], orow, lane); }
        }
    }
    grid.sync();

    for (int l = 0; l < DEPTH; ++l) {
        unsigned char* wl = ws + WS_W + (size_t)l * LW_SZ;
        { pg8::Gemm g{hb, (const bf16*)(wl + LW_IN), MMAIN, DINP, DM}; pg8::StaticOrder S; S.init(MMAIN, DINP, G, bid);
          pg8::EpiStore<0> E{pbuf, DINP};
          pg8::gemm_phase<pg8::EpiStore<0>, pg8::StaticOrder, true, true>((PG8_LAS unsigned char*)lds, g, S, E); }
        if (G == 256) { if (bid >= 128) side_gemm<0>(hb + (size_t)MMAIN * DM, (const bf16*)(wl + LW_IN), DM, DINP, pbuf + (size_t)MMAIN * DINP, DINP, 0.f, lds, bid - 128, 128); }
        else side_gemm<0>(hb + (size_t)MMAIN * DM, (const bf16*)(wl + LW_IN), DM, DINP, pbuf + (size_t)MMAIN * DINP, DINP, 0.f, lds, bid, G);
        GBAR();

#pragma unroll 1
        for (int it_ = 0; it_ < 3; ++it_) {
            const int ui = (it_ < 2) ? bid + G * it_ : ((bid < 10) ? 512 + (bid / 5) : -1);
            if (ui < 0 || (it_ < 2 && ui >= 512)) continue;
            const int segsel = (it_ < 2) ? 31 : (1 << (bid % 5));
            const int b = (ui < 512) ? (ui & 1) : (ui - 512), c = (ui < 512) ? 1 + (ui >> 1) : 0;
            const int row0 = (c == 0) ? MMAIN + 64 * b : b * SEQ + 64 * (c - 1), tv0 = (c == 0) ? PADT : 0, bci = b * NCH + c;
            const int hrb = (c == 1) ? MMAIN + 64 * b + 64 : row0;
            int tid = threadIdx.x; asm volatile("" : "+v"(tid)); unsigned char* ws = ws_g; asm volatile("" : "+s"(ws)); unsigned char* dsc = dsc_g; asm volatile("" : "+s"(dsc)); (void)ws; (void)dsc; const int lane = tid & 63, wave = __builtin_amdgcn_readfirstlane(tid >> 6); const int gw = bid * 8 + wave; (void)lane; (void)gw;
#ifndef NO_SEG_POOL
            if (segsel & 2) {
            int tid = threadIdx.x; asm volatile("" : "+v"(tid)); unsigned char* ws = ws_g; asm volatile("" : "+s"(ws)); unsigned char* dsc = dsc_g; asm volatile("" : "+s"(dsc)); (void)ws; (void)dsc; const int lane = tid & 63; (void)lane;
                typedef short bf16x8 __attribute__((ext_vector_type(8)));
                typedef unsigned u32x2 __attribute__((ext_vector_type(2)));
                bf16* ub = (bf16*)L;
                bf16* dB = (bf16*)(L + 10240);
                { u32x4 v[5];
#pragma unroll
                  for (int i = 0; i < 5; ++i) { const int idx = tid + NTHR * i, rr = idx >> 5, c8 = idx & 31, tl = rr - 16; const bool ok = (64 * c + tl >= PADT);
                      v[i] = (u32x4){0u, 0u, 0u, 0u}; if (ok) v[i] = *(const u32x4*)(pbuf + (size_t)(tl < 0 ? hrb + tl : row0 + tl) * DINP + PC_POOL + c8 * 8); }
#pragma unroll
                  for (int i = 0; i < 5; ++i) { const int idx = tid + NTHR * i; *(u32x4*)(ub + idx * 8) = v[i]; } }
                __syncthreads();
#pragma unroll 1
                for (int i = 0; i < 4; ++i) { const int idx = tid + NTHR * i, t = idx >> 5, c8 = idx & 31, g = c8 >> 3, w = 2 << g;
                    const int treal = 64 * c + t - PADT; const int cnt = (treal + 1 < w) ? treal + 1 : w;
                    float s[8];
#pragma unroll
                    for (int q = 0; q < 8; ++q) s[q] = 0.f;
                    for (int j = 0; j < w; ++j) { const u32x4 q4 = *(const u32x4*)(ub + (t + 16 - j) * 256 + c8 * 8);
                        s[0] += pg8::bflo(q4.x); s[1] += pg8::bfhi(q4.x); s[2] += pg8::bflo(q4.y); s[3] += pg8::bfhi(q4.y); s[4] += pg8::bflo(q4.z); s[5] += pg8::bfhi(q4.z); s[6] += pg8::bflo(q4.w); s[7] += pg8::bfhi(q4.w); }
                    const u32x4 c4 = *(const u32x4*)(ub + (t + 16) * 256 + c8 * 8);
                    const float cur[8] = {pg8::bflo(c4.x), pg8::bfhi(c4.x), pg8::bflo(c4.y), pg8::bfhi(c4.y), pg8::bflo(c4.z), pg8::bfhi(c4.z), pg8::bflo(c4.w), pg8::bfhi(c4.w)};
                    const float ic = (treal >= 0) ? 1.f / (float)cnt : 0.f;
                    float d[8];
#pragma unroll
                    for (int q = 0; q < 8; ++q) d[q] = (treal >= 0) ? s[q] * ic - cur[q] : 0.f;
                    u32x4 o; o.x = pk2(d[0], d[1]); o.y = pk2(d[2], d[3]); o.z = pk2(d[4], d[5]); o.w = pk2(d[6], d[7]);
                    *(u32x4*)(dB + t * 264 + c8 * 8) = o; }
                __syncthreads();
                {
                    const int wv_ = tid >> 6, g = wv_ & 3, th = wv_ >> 2, r = lane & 15, gq = lane >> 4;
                    const bf16* wt = (const bf16*)(ws + WS_WT3) + (size_t)((l * 3 + 0) * 4 + g) * 4096;
                    bf16x8 af[4][2];
#pragma unroll
                    for (int nt = 0; nt < 4; ++nt)
#pragma unroll
                        for (int kk = 0; kk < 2; ++kk) af[nt][kk] = *(const bf16x8*)(wt + (16 * nt + r) * 64 + 32 * kk + 8 * gq);
                    f32x4 acc[4][2];
#pragma unroll
                    for (int nt = 0; nt < 4; ++nt) { acc[nt][0] = (f32x4){0.f, 0.f, 0.f, 0.f}; acc[nt][1] = (f32x4){0.f, 0.f, 0.f, 0.f}; }
#pragma unroll
                    for (int tt = 0; tt < 2; ++tt)
#pragma unroll
                        for (int kk = 0; kk < 2; ++kk) { const bf16x8 bfr = *(const bf16x8*)(dB + (32 * th + 16 * tt + r) * 264 + g * 64 + 32 * kk + 8 * gq);
#pragma unroll
                            for (int nt = 0; nt < 4; ++nt) acc[nt][tt] = __builtin_amdgcn_mfma_f32_16x16x32_bf16(af[nt][kk], bfr, acc[nt][tt], 0, 0, 0); }
#pragma unroll
                    for (int nt = 0; nt < 4; ++nt) { const int col = g * 64 + 16 * nt + 4 * gq; const f32x4 sc = *(const f32x4*)(a.in[7] + l * 256 + col);
#pragma unroll
                        for (int tt = 0; tt < 2; ++tt) { const int t = 32 * th + 16 * tt + r; const bool val = t >= tv0;
                            u32x2 o; o.x = pk2(val ? acc[nt][tt][0] * sc[0] : 0.f, val ? acc[nt][tt][1] * sc[1] : 0.f); o.y = pk2(val ? acc[nt][tt][2] * sc[2] : 0.f, val ? acc[nt][tt][3] * sc[3] : 0.f);
                            *(u32x2*)(mix + (size_t)(row0 + t) * DM + col) = o; } }
                }
                __syncthreads();
            }
#endif
#ifndef NO_SEG_LRU1
            if (segsel & 4) {
            int tid = threadIdx.x; asm volatile("" : "+v"(tid)); unsigned char* ws = ws_g; asm volatile("" : "+s"(ws)); unsigned char* dsc = dsc_g; asm volatile("" : "+s"(dsc)); (void)ws; (void)dsc; const int lane = tid & 63; (void)lane;
                typedef short bf16x8 __attribute__((ext_vector_type(8)));
                typedef unsigned u32x2 __attribute__((ext_vector_type(2)));
                bf16* xb = (bf16*)L;
                bf16* gt = xb + 68 * 256;
                bf16* xcB = gt + 64 * 256;
                bf16* uB = xcB + 64 * 264;
                float* ex = (float*)(uB + 64 * 264);
                bf16* laB = xb;
                { u32x4 v[5], gv[4];
#pragma unroll
                  for (int i = 0; i < 5; ++i) { const int idx = tid + NTHR * i, rr = idx >> 5, c8 = idx & 31, tl = rr - 4; const bool ok = (idx < 68 * 32) && (64 * c + tl >= PADT);
                      v[i] = (u32x4){0u, 0u, 0u, 0u}; if (ok) v[i] = *(const u32x4*)(pbuf + (size_t)(tl < 0 ? hrb + tl : row0 + tl) * DINP + PC_LX + c8 * 8); }
#pragma unroll
                  for (int i = 0; i < 4; ++i) { const int idx = tid + NTHR * i, rr = idx >> 5, c8 = idx & 31; gv[i] = *(const u32x4*)(pbuf + (size_t)(row0 + rr) * DINP + PC_LG + c8 * 8); }
#pragma unroll
                  for (int i = 0; i < 5; ++i) { const int idx = tid + NTHR * i; if (idx < 68 * 32) *(u32x4*)(xb + idx * 8) = v[i]; }
#pragma unroll
                  for (int i = 0; i < 4; ++i) { const int idx = tid + NTHR * i; *(u32x4*)(gt + idx * 8) = gv[i]; } }
                __syncthreads();
                { const float* cw = a.in[22] + (size_t)l * 4 * 256; const float* cb = a.in[23] + l * 256;
#pragma unroll 1
                  for (int i = 0; i < 4; ++i) { const int idx = tid + NTHR * i, t = idx >> 5, c8 = idx & 31;
                    float o[8];
                    { const f32x4 b0 = *(const f32x4*)(cb + c8 * 8), b1 = *(const f32x4*)(cb + c8 * 8 + 4);
#pragma unroll
                      for (int q = 0; q < 4; ++q) { o[q] = b0[q]; o[4 + q] = b1[q]; } }
#pragma unroll
                    for (int j = 0; j < 4; ++j) { const u32x4 q4 = *(const u32x4*)(xb + (t + 1 + j) * 256 + c8 * 8);
                        const f32x4 w0 = *(const f32x4*)(cw + j * 256 + c8 * 8), w1 = *(const f32x4*)(cw + j * 256 + c8 * 8 + 4);
                        o[0] += w0[0] * pg8::bflo(q4.x); o[1] += w0[1] * pg8::bfhi(q4.x); o[2] += w0[2] * pg8::bflo(q4.y); o[3] += w0[3] * pg8::bfhi(q4.y);
                        o[4] += w1[0] * pg8::bflo(q4.z); o[5] += w1[1] * pg8::bfhi(q4.z); o[6] += w1[2] * pg8::bflo(q4.w); o[7] += w1[3] * pg8::bfhi(q4.w); }
                    const bool val = t >= tv0;
                    u32x4 ow; ow.x = pk2(val ? o[0] : 0.f, val ? o[1] : 0.f); ow.y = pk2(val ? o[2] : 0.f, val ? o[3] : 0.f); ow.z = pk2(val ? o[4] : 0.f, val ? o[5] : 0.f); ow.w = pk2(val ? o[6] : 0.f, val ? o[7] : 0.f);
                    *(u32x4*)(xcB + t * 264 + c8 * 8) = ow; } }
                __syncthreads();
                {
                    const int wv_ = tid >> 6, g = wv_ & 3, th = wv_ >> 2, r = lane & 15, gq = lane >> 4;
                    const bf16* wta = (const bf16*)(ws + WS_WT3) + (size_t)((l * 3 + 1) * 4 + g) * 4096; const bf16* wtx = (const bf16*)(ws + WS_WT3) + (size_t)((l * 3 + 2) * 4 + g) * 4096;
                    f32x4 accR[4][2], accI[4][2];
#pragma unroll
                    for (int nt = 0; nt < 4; ++nt) { accR[nt][0] = (f32x4){0.f, 0.f, 0.f, 0.f}; accR[nt][1] = accR[nt][0]; accI[nt][0] = accR[nt][0]; accI[nt][1] = accR[nt][0]; }
#pragma unroll
                    for (int kk = 0; kk < 2; ++kk) { bf16x8 b0 = *(const bf16x8*)(xcB + (32 * th + r) * 264 + g * 64 + 32 * kk + 8 * gq), b1 = *(const bf16x8*)(xcB + (32 * th + 16 + r) * 264 + g * 64 + 32 * kk + 8 * gq);
#pragma unroll
                        for (int nt = 0; nt < 4; ++nt) { const bf16x8 fa = *(const bf16x8*)(wta + (16 * nt + r) * 64 + 32 * kk + 8 * gq), fx = *(const bf16x8*)(wtx + (16 * nt + r) * 64 + 32 * kk + 8 * gq);
                            accR[nt][0] = __builtin_amdgcn_mfma_f32_16x16x32_bf16(fa, b0, accR[nt][0], 0, 0, 0); accR[nt][1] = __builtin_amdgcn_mfma_f32_16x16x32_bf16(fa, b1, accR[nt][1], 0, 0, 0);
                            accI[nt][0] = __builtin_amdgcn_mfma_f32_16x16x32_bf16(fx, b0, accI[nt][0], 0, 0, 0); accI[nt][1] = __builtin_amdgcn_mfma_f32_16x16x32_bf16(fx, b1, accI[nt][1], 0, 0, 0); } }
#pragma unroll
                    for (int nt = 0; nt < 4; ++nt) { const int col = g * 64 + 16 * nt + 4 * gq;
                        const f32x4 gab = *(const f32x4*)(a.in[25] + l * 256 + col), gxb = *(const f32x4*)(a.in[27] + l * 256 + col), lam = *(const f32x4*)(a.in[28] + l * 256 + col);
#pragma unroll
                        for (int tt = 0; tt < 2; ++tt) { const int t = 32 * th + 16 * tt + r; const u32x2 xw = *(const u32x2*)(xcB + t * 264 + col);
                            const float xv[4] = {pg8::bflo(xw.x), pg8::bfhi(xw.x), pg8::bflo(xw.y), pg8::bfhi(xw.y)}; float la[4], uu[4];
#pragma unroll
                            for (int i = 0; i < 4; ++i) { const float rr = sigmoidf_(accR[nt][tt][i] + gab[i]), ig = sigmoidf_(accI[nt][tt][i] + gxb[i]); la[i] = -8.f * rr * softplusf_(-lam[i]); uu[i] = sqrtf(1.f - __expf(2.f * la[i])) * (ig * xv[i]); }
                            u32x2 lo_, uo_; lo_.x = pk2(la[0], la[1]); lo_.y = pk2(la[2], la[3]); uo_.x = pk2(uu[0], uu[1]); uo_.y = pk2(uu[2], uu[3]);
                            *(u32x2*)(laB + t * 264 + col) = lo_; *(u32x2*)(uB + t * 264 + col) = uo_; } }
                }
                __syncthreads();
                const int col = tid & 255, th = tid >> 8;
                float hh = 0.f, AA = 1.f;
#pragma unroll
                for (int half = 0; half < 2; ++half) {
                    if (th == half) {
                        if (half == 1) { hh = ex[col]; AA = ex[256 + col]; }
#pragma unroll 4
                        for (int i = 0; i < 32; ++i) { const int t = th * 32 + i; const size_t row = (size_t)(row0 + t);
                            float o1 = 0.f, o2 = 0.f;
                            if (t >= tv0) { const float av = __expf(bf2f(laB[t * 264 + col])); hh = av * hh + bf2f(uB[t * 264 + col]); AA *= av;
                                const float gl = gelu_tanh(bf2f(gt[t * 256 + col])); o1 = hh * gl; o2 = AA * gl; }
                            mix[row * DM + 512 + col] = (bf16)f2bf(o1); acg[row * 256 + col] = (bf16)f2bf(o2); }
                        if (half == 0) { ex[col] = hh; ex[256 + col] = AA; } else { lruA[bci * 256 + col] = AA; lruH[bci * 256 + col] = hh; }
                    }
                    __syncthreads();
                }
            }
#endif
#ifndef NO_SEG_ML1
            if (segsel & 8) {
            int tid = threadIdx.x; asm volatile("" : "+v"(tid)); unsigned char* ws = ws_g; asm volatile("" : "+s"(ws)); unsigned char* dsc = dsc_g; asm volatile("" : "+s"(dsc)); (void)ws; (void)dsc; const int lane = tid & 63; (void)lane;
                typedef short bf16x8 __attribute__((ext_vector_type(8)));
                float* li = L, *bc = L + 256, *wl = L + 512;
                bf16* VwT = (bf16*)(L + 2048);
                bf16* KT = VwT + 256 * 72;
                ml_gates<1>(pbuf, a.in[29], l, row0, tv0, bci, li, bc, wl, nullptr, nullptr, mlM, mlB, nullptr, tid);
                { u32x4 kv[4], vv[4];
#pragma unroll
                  for (int i = 0; i < 4; ++i) { const int idx = tid + NTHR * i, s = idx & 63, c8 = idx >> 6; const bf16* src = pbuf + (size_t)(row0 + s) * DINP + c8 * 8;
                      kv[i] = *(const u32x4*)(src + PC_MK); vv[i] = *(const u32x4*)(src + PC_MV); }
#pragma unroll
                  for (int i = 0; i < 4; ++i) { const int idx = tid + NTHR * i, s = idx & 63, c8 = idx >> 6; const float w = wl[s * 4 + (c8 >> 3)];
                      bf16* dk = KT + (size_t)(c8 * 8) * 72 + s; bf16* dv = VwT + (size_t)(c8 * 8) * 72 + s;
                      dk[0 * 72] = (bf16)(kv[i].x & 0xffffu); dk[1 * 72] = (bf16)(kv[i].x >> 16); dk[2 * 72] = (bf16)(kv[i].y & 0xffffu); dk[3 * 72] = (bf16)(kv[i].y >> 16);
                      dk[4 * 72] = (bf16)(kv[i].z & 0xffffu); dk[5 * 72] = (bf16)(kv[i].z >> 16); dk[6 * 72] = (bf16)(kv[i].w & 0xffffu); dk[7 * 72] = (bf16)(kv[i].w >> 16);
                      dv[0 * 72] = (bf16)f2bf(pg8::bflo(vv[i].x) * w); dv[1 * 72] = (bf16)f2bf(pg8::bfhi(vv[i].x) * w); dv[2 * 72] = (bf16)f2bf(pg8::bflo(vv[i].y) * w); dv[3 * 72] = (bf16)f2bf(pg8::bfhi(vv[i].y) * w);
                      dv[4 * 72] = (bf16)f2bf(pg8::bflo(vv[i].z) * w); dv[5 * 72] = (bf16)f2bf(pg8::bfhi(vv[i].z) * w); dv[6 * 72] = (bf16)f2bf(pg8::bflo(vv[i].w) * w); dv[7 * 72] = (bf16)f2bf(pg8::bfhi(vv[i].w) * w); } }
                __syncthreads();
                {
                    const int wv_ = tid >> 6, h = wv_ >> 1, vh = wv_ & 1, r = lane & 15, gq = lane >> 4;
                    f32x4 acc[2][4];
#pragma unroll
                    for (int vt = 0; vt < 2; ++vt)
#pragma unroll
                        for (int kt = 0; kt < 4; ++kt) acc[vt][kt] = (f32x4){0.f, 0.f, 0.f, 0.f};
#pragma unroll
                    for (int kk = 0; kk < 2; ++kk) { bf16x8 af[2];
#pragma unroll
                        for (int vt = 0; vt < 2; ++vt) af[vt] = *(const bf16x8*)(VwT + (size_t)(h * 64 + 32 * vh + 16 * vt + r) * 72 + 32 * kk + 8 * gq);
#pragma unroll
                        for (int kt = 0; kt < 4; ++kt) { const bf16x8 bfr = *(const bf16x8*)(KT + (size_t)(h * 64 + 16 * kt + r) * 72 + 32 * kk + 8 * gq);
#pragma unroll
                            for (int vt = 0; vt < 2; ++vt) acc[vt][kt] = __builtin_amdgcn_mfma_f32_16x16x32_bf16(af[vt], bfr, acc[vt][kt], 0, 0, 0); } }
                    float* cdst = mlC + (size_t)(bci * 4 + h) * 4096;
#pragma unroll
                    for (int vt = 0; vt < 2; ++vt)
#pragma unroll
                        for (int kt = 0; kt < 4; ++kt)
#pragma unroll
                            for (int i = 0; i < 4; ++i) cdst[(size_t)(32 * vh + 16 * vt + 4 * gq + i) * 64 + 16 * kt + r] = acc[vt][kt][i];
                    if (tid < 256) { const int hh_ = tid >> 6, k = tid & 63; float nacc = 0.f; const bf16* kr = KT + (size_t)(hh_ * 64 + k) * 72;
#pragma unroll 8
                        for (int s = 0; s < 64; ++s) nacc += wl[s * 4 + hh_] * bf2f(kr[s]);
                        mlN[(size_t)(bci * 4 + hh_) * 64 + k] = nacc; }
                }
                __syncthreads();
            }
#endif
#ifndef NO_SEG_RW1
            if (segsel & 17) {
            int tid = threadIdx.x; asm volatile("" : "+v"(tid)); unsigned char* ws = ws_g; asm volatile("" : "+s"(ws)); unsigned char* dsc = dsc_g; asm volatile("" : "+s"(dsc)); (void)ws; (void)dsc; const int lane = tid & 63; (void)lane;
                const int wv_ = __builtin_amdgcn_readfirstlane(tid >> 6);
                int ui_l = __builtin_amdgcn_readfirstlane(ui); asm volatile("" : "+s"(ui_l)); bf16* LO = (bf16*)(ws + WS_LORA) + (size_t)ui_l * 64 * 256 * 4;
                rw_lora<3>(a, pbuf, LO, L, l, c, row0, hrb, tid);
                { unsigned z0; asm volatile("v_mov_b32 %0, 0" : "=v"(z0)); const u32x4 zz = {z0, z0, z0, z0};
                  for (int i = tid; i < WY_UVB / 16; i += NTHR) { ((u32x4*)(lds + WY_UV))[i] = zz; ((u32x4*)(lds + WY_VP))[i] = zz; } }
                const int h = wv_ & 3, r = lane & 15, g = lane >> 4; const bool pm = wv_ >= 4;
                f32x4 acc[4][4];
                { float z0; asm volatile("v_mov_b32 %0, 0" : "=v"(z0));
#pragma unroll
                  for (int jt = 0; jt < 4; ++jt)
#pragma unroll
                      for (int rt = 0; rt < 4; ++rt) { f32x4 x = {z0, z0, z0, z0};
                          if (pm && jt == rt) {
#pragma unroll
                              for (int i = 0; i < 4; ++i) x[i] = (4 * g + i == r) ? 1.f : 0.f; }
                          acc[jt][rt] = x; } }
                __syncthreads();
                for (int blk = 0; blk < 4; ++blk) {
                    const int ts = blk * 16;
                    if (ts + 16 <= tv0) continue;
                    wy_prep<1>(a, pbuf, vfirst, LO, lds, l, c, row0, hrb, ts, tid);
                    if (!pm && (segsel & 1)) wy_block<1>(acc, lds, h, lane, (bf16*)(lds + WY_UV) + (size_t)h * 64 * WY_TS, lds + WY_SCR + h * WY_WSCR, (float*)(lds + WY_SCR + h * WY_WSCR + 3584), nullptr, nullptr, nullptr);
                    __syncthreads();
                    if (pm && (segsel & 16)) wy_block<1>(acc, lds, h, lane, (bf16*)(lds + WY_VP) + (size_t)h * 64 * WY_TS, lds + WY_SCR + h * WY_WSCR, (float*)(lds + WY_SCR + h * WY_WSCR + 3584), nullptr, nullptr, nullptr);
                    __syncthreads();
                }
                if (pm ? !(segsel & 16) : !(segsel & 1)) { } else
                if (pm) {
                    bf16* dst = (bf16*)(rwP + (size_t)(bci * 4 + h) * 4096);
#pragma unroll
                    for (int jt = 0; jt < 4; ++jt)
#pragma unroll
                        for (int rt = 0; rt < 4; ++rt)
#pragma unroll
                            for (int i = 0; i < 4; ++i) { const int kk = rt >> 1, gp = (r >> 2) & 3, e = ((rt & 1) << 2) | (r & 3), rl = 4 * g + i;
                                dst[((jt * 2 + kk) * 64 + gp * 16 + rl) * 8 + e] = (bf16)f2bf(acc[jt][rt][i]); }
                } else {
                    float* dst = rwS + (size_t)(bci * 4 + h) * 4096;
#pragma unroll
                    for (int jt = 0; jt < 4; ++jt)
#pragma unroll
                        for (int rt = 0; rt < 4; ++rt) *(f32x4*)(dst + ((rt * 4 + jt) * 64 + g * 16 + r) * 4) = acc[jt][rt];
                }
            }
#endif
        }
        GBAR();

#ifndef NO_PC
        {
        int tid = threadIdx.x; asm volatile("" : "+v"(tid)); unsigned char* ws = ws_g; asm volatile("" : "+s"(ws)); unsigned char* dsc = dsc_g; asm volatile("" : "+s"(dsc)); (void)ws; (void)dsc; const int lane = tid & 63, wave = __builtin_amdgcn_readfirstlane(tid >> 6); const int gw = bid * 8 + wave; (void)lane; (void)gw;
        if (bid < 64) {
            const int bh = bid >> 3, b = bh >> 2, h = bh & 3, e = (bid & 7) * 512 + tid;
            float cst = 0.f, nst = 0.f, m = 0.f; const bool don = ((bid & 7) == 0) && tid < 64;
            for (int c0 = 0; c0 < NCH; c0 += 8) {
                float cl[8], nl[8], ml_[8], bl_[8];
#pragma unroll
                for (int i = 0; i < 8; ++i) { const int c = c0 + i; if (c < NCH) { const int bci = b * NCH + c; cl[i] = mlC[(size_t)(bci * 4 + h) * 4096 + e]; nl[i] = don ? mlN[(size_t)(bci * 4 + h) * 64 + tid] : 0.f; ml_[i] = mlM[bci * 4 + h]; bl_[i] = mlB[bci * 4 + h]; } else { cl[i] = 0.f; nl[i] = 0.f; ml_[i] = 0.f; bl_[i] = 0.f; } }
#pragma unroll
                for (int i = 0; i < 8; ++i) { const int c = c0 + i; if (c < NCH) { const int bci = b * NCH + c;
                        mlC[(size_t)(bci * 4 + h) * 4096 + e] = cst; if (don) mlN[(size_t)(bci * 4 + h) * 64 + tid] = nst; if ((bid & 7) == 0 && tid == 0) mlP[bci * 4 + h] = m;
                        const float mn = fmaxf(bl_[i] + m, ml_[i]); const float so = __expf(bl_[i] + m - mn), sn = __expf(ml_[i] - mn);
                        cst = so * cst + sn * cl[i]; nst = so * nst + sn * nl[i]; m = mn; } }
            }
        } else if (bid < 72) {
            typedef short bf16x8 __attribute__((ext_vector_type(8)));
            const int bh = bid - 64, b = bh >> 2, h = bh & 3;
            constexpr int SLOT = 24576, DEPTH_R = 5;
            PG8_LAS unsigned char* ring = (PG8_LAS unsigned char*)lds;
            const char* gP = (const char*)(rwP + (size_t)((b * NCH) * 4 + h) * 4096); const char* gS = (const char*)(rwS + (size_t)((b * NCH) * 4 + h) * 4096);
            const size_t cstride = (size_t)4 * 4096 * 4;
#define RWC_ISSUE(cc) { const int c_ = ((cc) < NCH) ? (cc) : NCH - 1; const int s_ = (cc) % DEPTH_R; _Pragma("unroll") for (int q = 0; q < 6; ++q) { const int pi = q * 4 + (wave - 4); \
                const char* src = (pi < 8) ? gP + (size_t)c_ * cstride + pi * 1024 + lane * 16 : gS + (size_t)c_ * cstride + (pi - 8) * 1024 + lane * 16; \
                __builtin_amdgcn_global_load_lds((const unsigned*)src, (PG8_LAS unsigned*)(ring + s_ * SLOT + pi * 1024), 16, 0, 0); } }
            f32x4 acc[4];
#pragma unroll
            for (int jt = 0; jt < 4; ++jt) acc[jt] = (f32x4){0.f, 0.f, 0.f, 0.f};
            if (wave >= 4) { RWC_ISSUE(0); RWC_ISSUE(1); RWC_ISSUE(2); RWC_ISSUE(3); }
            const int rl = lane & 15, g = lane >> 4;
            for (int c = 0; c < NCH; ++c) {
                if (wave >= 4) asm volatile("s_waitcnt vmcnt(18)" ::: "memory");
                asm volatile("" ::: "memory"); __builtin_amdgcn_s_barrier(); asm volatile("" ::: "memory");
                if (wave >= 4) { RWC_ISSUE(c + 4); }
                else {
                    const PG8_LAS unsigned char* sl = ring + (c % DEPTH_R) * SLOT;
                    f32x4 lf[4]; bf16x8 af[4][2];
#pragma unroll
                    for (int jt = 0; jt < 4; ++jt) { lf[jt] = *(const PG8_LAS f32x4*)(sl + 8192 + ((wave * 4 + jt) * 64 + lane) * 16);
                        af[jt][0] = *(const PG8_LAS bf16x8*)(sl + ((jt * 2 + 0) * 64 + lane) * 16); af[jt][1] = *(const PG8_LAS bf16x8*)(sl + ((jt * 2 + 1) * 64 + lane) * 16); }
                    float* so = rwS + (size_t)((b * NCH + c) * 4 + h) * 4096 + (size_t)(16 * wave + rl) * 64 + 4 * g;
#pragma unroll
                    for (int jt = 0; jt < 4; ++jt) *(f32x4*)(so + 16 * jt) = acc[jt];
                    bf16x8 bh_[2], bl_[2];
#pragma unroll
                    for (int kk = 0; kk < 2; ++kk) { u32x4 hw, lw; const f32x4 x = acc[2 * kk], y = acc[2 * kk + 1];
                        hw.x = pg8::cvt_pk_bf16(x[0], x[1]); hw.y = pg8::cvt_pk_bf16(x[2], x[3]); hw.z = pg8::cvt_pk_bf16(y[0], y[1]); hw.w = pg8::cvt_pk_bf16(y[2], y[3]);
                        lw.x = pg8::cvt_pk_bf16(x[0] - pg8::bflo(hw.x), x[1] - pg8::bfhi(hw.x)); lw.y = pg8::cvt_pk_bf16(x[2] - pg8::bflo(hw.y), x[3] - pg8::bfhi(hw.y));
                        lw.z = pg8::cvt_pk_bf16(y[0] - pg8::bflo(hw.z), y[1] - pg8::bfhi(hw.z)); lw.w = pg8::cvt_pk_bf16(y[2] - pg8::bflo(hw.w), y[3] - pg8::bfhi(hw.w));
                        bh_[kk] = __builtin_bit_cast(bf16x8, hw); bl_[kk] = __builtin_bit_cast(bf16x8, lw); }
#pragma unroll
                    for (int jt = 0; jt < 4; ++jt) { f32x4 n = lf[jt];
#pragma unroll
                        for (int kk = 0; kk < 2; ++kk) { n = __builtin_amdgcn_mfma_f32_16x16x32_bf16(af[jt][kk], bh_[kk], n, 0, 0, 0); n = __builtin_amdgcn_mfma_f32_16x16x32_bf16(af[jt][kk], bl_[kk], n, 0, 0, 0); }
                        acc[jt] = n; }
                }
            }
            asm volatile("s_waitcnt vmcnt(0)" ::: "memory");
            __builtin_amdgcn_s_barrier();
#undef RWC_ISSUE
        } else if (bid == 128) {
            const int b = tid >> 8, col = tid & 255; float hh = 0.f;
            for (int c0 = 0; c0 < NCH; c0 += 8) {
                float A8[8], H8[8];
#pragma unroll
                for (int i = 0; i < 8; ++i) { const int c = c0 + i; if (c < NCH) { A8[i] = lruA[(b * NCH + c) * 256 + col]; H8[i] = lruH[(b * NCH + c) * 256 + col]; } else { A8[i] = 1.f; H8[i] = 0.f; } }
#pragma unroll
                for (int i = 0; i < 8; ++i) { const int c = c0 + i; if (c < NCH) { lruS[(b * NCH + c) * 256 + col] = hh; hh = A8[i] * hh + H8[i]; } }
            }
        }
        }
#endif

#pragma unroll 1
        for (int it_ = 0; it_ < 3; ++it_) {
            if (it_ == 1) GBAR();
            const int q0_ = G - 1 - bid; const int ui = (it_ == 0) ? (((unsigned)q0_ < 2u) ? 512 + q0_ : -1) : bid + G * (it_ - 1);
            if (ui < 0 || (it_ > 0 && ui >= 512)) continue;
            const int rep_ = 0; (void)rep_;
            const int b = (ui < 512) ? (ui & 1) : (ui - 512), c = (ui < 512) ? 1 + (ui >> 1) : 0;
            const int row0 = (c == 0) ? MMAIN + 64 * b : b * SEQ + 64 * (c - 1), tv0 = (c == 0) ? PADT : 0, bci = b * NCH + c;
            const int hrb = (c == 1) ? MMAIN + 64 * b + 64 : row0;
            int tid = threadIdx.x; asm volatile("" : "+v"(tid)); unsigned char* ws = ws_g; asm volatile("" : "+s"(ws)); unsigned char* dsc = dsc_g; asm volatile("" : "+s"(dsc)); (void)ws; (void)dsc; const int lane = tid & 63, wave = __builtin_amdgcn_readfirstlane(tid >> 6); const int gw = bid * 8 + wave; (void)lane; (void)gw;
            if (c > 0) { u32x4 mv[4], av[4];
#pragma unroll
                for (int i = 0; i < 4; ++i) { const int idx = tid + NTHR * i, t = idx >> 5, c8 = idx & 31; const size_t row = (size_t)(row0 + t);
                    mv[i] = *(const u32x4*)(mix + row * DM + 512 + c8 * 8); av[i] = *(const u32x4*)(acg + row * 256 + c8 * 8); }
#pragma unroll
                for (int i = 0; i < 4; ++i) { const int idx = tid + NTHR * i, t = idx >> 5, c8 = idx & 31; const size_t row = (size_t)(row0 + t);
                    const f32x4 s0 = *(const f32x4*)(lruS + bci * 256 + c8 * 8), s1 = *(const f32x4*)(lruS + bci * 256 + c8 * 8 + 4);
                    u32x4 o; o.x = pk2(pg8::bflo(mv[i].x) + pg8::bflo(av[i].x) * s0[0], pg8::bfhi(mv[i].x) + pg8::bfhi(av[i].x) * s0[1]);
                    o.y = pk2(pg8::bflo(mv[i].y) + pg8::bflo(av[i].y) * s0[2], pg8::bfhi(mv[i].y) + pg8::bfhi(av[i].y) * s0[3]);
                    o.z = pk2(pg8::bflo(mv[i].z) + pg8::bflo(av[i].z) * s1[0], pg8::bfhi(mv[i].z) + pg8::bfhi(av[i].z) * s1[1]);
                    o.w = pk2(pg8::bflo(mv[i].w) + pg8::bflo(av[i].w) * s1[2], pg8::bfhi(mv[i].w) + pg8::bfhi(av[i].w) * s1[3]);
                    *(u32x4*)(mix + row * DM + 512 + c8 * 8) = o; } }
#ifndef NO_SEG_ML3
            {
            int tid = threadIdx.x; asm volatile("" : "+v"(tid)); unsigned char* ws = ws_g; asm volatile("" : "+s"(ws)); unsigned char* dsc = dsc_g; asm volatile("" : "+s"(dsc)); (void)ws; (void)dsc; const int lane = tid & 63; (void)lane;
                typedef short bf16x8 __attribute__((ext_vector_type(8)));
                float* li = L, *bc = L + 256, *mt = L + 512, *wint = L + 768, *np = L + 1024;
                bf16* VT = (bf16*)(L + 2048);
                ml_gates<3>(pbuf, a.in[29], l, row0, tv0, bci, li, bc, nullptr, mt, wint, nullptr, nullptr, mlP, tid);
                { u32x4 vv[4];
#pragma unroll
                  for (int i = 0; i < 4; ++i) { const int idx = tid + NTHR * i, s = idx & 63, c8 = idx >> 6; vv[i] = *(const u32x4*)(pbuf + (size_t)(row0 + s) * DINP + PC_MV + c8 * 8); }
#pragma unroll
                  for (int i = 0; i < 4; ++i) { const int idx = tid + NTHR * i, s = idx & 63, c8 = idx >> 6; bf16* d = VT + (size_t)(c8 * 8) * 72 + s;
                      d[0 * 72] = (bf16)(vv[i].x & 0xffffu); d[1 * 72] = (bf16)(vv[i].x >> 16); d[2 * 72] = (bf16)(vv[i].y & 0xffffu); d[3 * 72] = (bf16)(vv[i].y >> 16);
                      d[4 * 72] = (bf16)(vv[i].z & 0xffffu); d[5 * 72] = (bf16)(vv[i].z >> 16); d[6 * 72] = (bf16)(vv[i].w & 0xffffu); d[7 * 72] = (bf16)(vv[i].w >> 16); }
                  if (tid < 256) np[tid] = (c > 0) ? mlN[(size_t)(bci * 4) * 64 + tid] : 0.f; }
                __syncthreads();
                const int wv_ = tid >> 6, h = wv_ >> 1, th = wv_ & 1, r = lane & 15, g = lane >> 4;
                bf16x8 qf[2][2];
#pragma unroll
                for (int nt = 0; nt < 2; ++nt)
#pragma unroll
                    for (int kk = 0; kk < 2; ++kk) qf[nt][kk] = *(const bf16x8*)(pbuf + (size_t)(row0 + 32 * th + 16 * nt + r) * DINP + PC_MQ + h * 64 + 32 * kk + 8 * g);
                f32x4 accS[4][2];
#pragma unroll
                for (int ms = 0; ms < 4; ++ms) { accS[ms][0] = (f32x4){0.f, 0.f, 0.f, 0.f}; accS[ms][1] = (f32x4){0.f, 0.f, 0.f, 0.f}; }
#pragma unroll
                for (int ms = 0; ms < 4; ++ms)
#pragma unroll
                    for (int kk = 0; kk < 2; ++kk) { const bf16x8 kf = *(const bf16x8*)(pbuf + (size_t)(row0 + 16 * ms + r) * DINP + PC_MK + h * 64 + 32 * kk + 8 * g);
#pragma unroll
                        for (int nt = 0; nt < 2; ++nt) accS[ms][nt] = __builtin_amdgcn_mfma_f32_16x16x32_bf16(kf, qf[nt][kk], accS[ms][nt], 0, 0, 0); }
                float dsum[2], mtt[2], wit[2];
#pragma unroll
                for (int nt = 0; nt < 2; ++nt) { const int t = 32 * th + 16 * nt + r; const float bct = bc[t * 4 + h]; mtt[nt] = mt[t * 4 + h]; wit[nt] = wint[t * 4 + h]; float ds = 0.f;
#pragma unroll
                    for (int ms = 0; ms < 4; ++ms)
#pragma unroll
                        for (int i = 0; i < 4; ++i) { const int s = 16 * ms + 4 * g + i; float e = 0.f;
                            if (s <= t && s >= tv0 && t >= tv0) e = 0.125f * __expf(bct - bc[s * 4 + h] + li[s * 4 + h] - mtt[nt]);
                            const float pv = accS[ms][nt][i] * e; accS[ms][nt][i] = pv; ds += pv; }
                    ds += __shfl_xor(ds, 16); ds += __shfl_xor(ds, 32); dsum[nt] = ds; }
                bf16x8 pf[2][2];
#pragma unroll
                for (int nt = 0; nt < 2; ++nt)
#pragma unroll
                    for (int kk = 0; kk < 2; ++kk) { u32x4 w; w.x = pg8::cvt_pk_bf16(accS[2 * kk][nt][0], accS[2 * kk][nt][1]); w.y = pg8::cvt_pk_bf16(accS[2 * kk][nt][2], accS[2 * kk][nt][3]);
                        w.z = pg8::cvt_pk_bf16(accS[2 * kk + 1][nt][0], accS[2 * kk + 1][nt][1]); w.w = pg8::cvt_pk_bf16(accS[2 * kk + 1][nt][2], accS[2 * kk + 1][nt][3]); pf[nt][kk] = __builtin_bit_cast(bf16x8, w); }
                f32x4 num[4][2];
#pragma unroll
                for (int mv = 0; mv < 4; ++mv) { num[mv][0] = (f32x4){0.f, 0.f, 0.f, 0.f}; num[mv][1] = (f32x4){0.f, 0.f, 0.f, 0.f}; }
#pragma unroll
                for (int mv = 0; mv < 4; ++mv)
#pragma unroll
                    for (int kk = 0; kk < 2; ++kk) { const bf16* vp = VT + (size_t)(h * 64 + 16 * mv + r) * 72 + 32 * kk + 4 * g;
                        typedef unsigned u32x2 __attribute__((ext_vector_type(2)));
                        const u32x2 lo = *(const u32x2*)vp, hi = *(const u32x2*)(vp + 16); u32x4 w; w.x = lo.x; w.y = lo.y; w.z = hi.x; w.w = hi.y; const bf16x8 vf = __builtin_bit_cast(bf16x8, w);
#pragma unroll
                        for (int nt = 0; nt < 2; ++nt) num[mv][nt] = __builtin_amdgcn_mfma_f32_16x16x32_bf16(vf, pf[nt][kk], num[mv][nt], 0, 0, 0); }
                bf16x8 qs[2][2]; float nq[2];
#pragma unroll
                for (int nt = 0; nt < 2; ++nt) { float nqa = 0.f; const float sc = 0.125f * wit[nt];
#pragma unroll
                    for (int kk = 0; kk < 2; ++kk) { const u32x4 w = __builtin_bit_cast(u32x4, qf[nt][kk]);
                        const float f[8] = {pg8::bflo(w.x) * sc, pg8::bfhi(w.x) * sc, pg8::bflo(w.y) * sc, pg8::bfhi(w.y) * sc, pg8::bflo(w.z) * sc, pg8::bfhi(w.z) * sc, pg8::bflo(w.w) * sc, pg8::bfhi(w.w) * sc};
                        const f32x4 n0 = *(const f32x4*)&np[h * 64 + 32 * kk + 8 * g], n1 = *(const f32x4*)&np[h * 64 + 32 * kk + 8 * g + 4];
                        nqa += f[0] * n0.x + f[1] * n0.y + f[2] * n0.z + f[3] * n0.w + f[4] * n1.x + f[5] * n1.y + f[6] * n1.z + f[7] * n1.w;
                        u32x4 o; o.x = pg8::cvt_pk_bf16(f[0], f[1]); o.y = pg8::cvt_pk_bf16(f[2], f[3]); o.z = pg8::cvt_pk_bf16(f[4], f[5]); o.w = pg8::cvt_pk_bf16(f[6], f[7]); qs[nt][kk] = __builtin_bit_cast(bf16x8, o); }
                    nqa += __shfl_xor(nqa, 16); nqa += __shfl_xor(nqa, 32); nq[nt] = nqa; }
#pragma unroll
                for (int mv = 0; mv < 4; ++mv)
#pragma unroll
                    for (int kk = 0; kk < 2; ++kk) { const float* cp = mlC + (size_t)(bci * 4 + h) * 4096 + (size_t)(16 * mv + r) * 64 + 32 * kk + 8 * g;
                        f32x4 c0 = {0.f, 0.f, 0.f, 0.f}, c1 = c0; if (c > 0) { c0 = *(const f32x4*)cp; c1 = *(const f32x4*)(cp + 4); }
                        u32x4 o; o.x = pg8::cvt_pk_bf16(c0.x, c0.y); o.y = pg8::cvt_pk_bf16(c0.z, c0.w); o.z = pg8::cvt_pk_bf16(c1.x, c1.y); o.w = pg8::cvt_pk_bf16(c1.z, c1.w); const bf16x8 cf = __builtin_bit_cast(bf16x8, o);
#pragma unroll
                        for (int nt = 0; nt < 2; ++nt) num[mv][nt] = __builtin_amdgcn_mfma_f32_16x16x32_bf16(cf, qs[nt][kk], num[mv][nt], 0, 0, 0); }
#pragma unroll
                for (int nt = 0; nt < 2; ++nt) { const int t = 32 * th + 16 * nt + r; const size_t row = (size_t)(row0 + t);
                    const float den = dsum[nt] + nq[nt]; const float inv = 1.f / fmaxf(fabsf(den), __expf(-mtt[nt]));
                    float s1 = 0.f;
#pragma unroll
                    for (int mv = 0; mv < 4; ++mv)
#pragma unroll
                        for (int i = 0; i < 4; ++i) { num[mv][nt][i] *= inv; s1 += num[mv][nt][i]; }
                    s1 += __shfl_xor(s1, 16); s1 += __shfl_xor(s1, 32);
                    const float mean = s1 * (1.f / 64.f); float s2 = 0.f;
#pragma unroll
                    for (int mv = 0; mv < 4; ++mv)
#pragma unroll
                        for (int i = 0; i < 4; ++i) { num[mv][nt][i] -= mean; s2 += num[mv][nt][i] * num[mv][nt][i]; }
                    s2 += __shfl_xor(s2, 16); s2 += __shfl_xor(s2, 32);
                    const float rstd = 1.f / sqrtf(s2 * (1.f / 64.f) + GN_EPS);
#pragma unroll
                    for (int mv = 0; mv < 4; ++mv) { const int v0 = h * 64 + 16 * mv + 4 * g;
                        typedef unsigned u32x2 __attribute__((ext_vector_type(2)));
                        const u32x2 ov = *(const u32x2*)(pbuf + row * DINP + PC_MO + v0);
                        const f32x4 gg = *(const f32x4*)(a.in[30] + l * 256 + v0), gb = *(const f32x4*)(a.in[31] + l * 256 + v0);
                        float y[4]; const float o4[4] = {pg8::bflo(ov.x), pg8::bfhi(ov.x), pg8::bflo(ov.y), pg8::bfhi(ov.y)};
#pragma unroll
                        for (int i = 0; i < 4; ++i) { y[i] = (num[mv][nt][i] * rstd * gg[i] + gb[i]) * sigmoidf_(o4[i]); if (t < tv0) y[i] = 0.f; }
                        u32x2 ow; ow.x = pk2(y[0], y[1]); ow.y = pk2(y[2], y[3]);
                        *(u32x2*)(mix + row * DM + 768 + v0) = ow; }
                }
                __syncthreads();
            }
#endif
#ifndef NO_SEG_RW3
            {
            int tid = threadIdx.x; asm volatile("" : "+v"(tid)); unsigned char* ws = ws_g; asm volatile("" : "+s"(ws)); unsigned char* dsc = dsc_g; asm volatile("" : "+s"(dsc)); (void)ws; (void)dsc; const int lane = tid & 63; (void)lane;
                const int wv_ = __builtin_amdgcn_readfirstlane(tid >> 6);
                int ui_l = __builtin_amdgcn_readfirstlane(ui); asm volatile("" : "+s"(ui_l)); const bf16* LO = (const bf16*)(ws + WS_LORA) + (size_t)ui_l * 64 * 256 * 4;
                { unsigned z0; asm volatile("v_mov_b32 %0, 0" : "=v"(z0)); const u32x4 zz = {z0, z0, z0, z0}; for (int i = tid; i < WY_UVB / 16; i += NTHR) ((u32x4*)(lds + WY_UV))[i] = zz; }
                const int h = wv_ & 3, r = lane & 15, g = lane >> 4;
                f32x4 acc[4][4];
                if (wv_ < 4) { const float* src = rwS + (size_t)(bci * 4 + h) * 4096;
#pragma unroll
                    for (int jt = 0; jt < 4; ++jt)
#pragma unroll
                        for (int rt = 0; rt < 4; ++rt) { f32x4 x = {0.f, 0.f, 0.f, 0.f}; if (c > 0) x = *(const f32x4*)(src + (size_t)(16 * rt + r) * 64 + 16 * jt + 4 * g); acc[jt][rt] = x; } }
                else { float z0; asm volatile("v_mov_b32 %0, 0" : "=v"(z0));
#pragma unroll
                    for (int jt = 0; jt < 4; ++jt)
#pragma unroll
                        for (int rt = 0; rt < 4; ++rt) acc[jt][rt] = (f32x4){z0, z0, z0, z0}; }
                __syncthreads();
                for (int blk = 0; blk < 4; ++blk) {
                    const int ts = blk * 16;
                    if (ts + 16 <= tv0) { if (tid < 256) { for (int j = 0; j < 16; ++j) mix[(size_t)(row0 + ts + j) * DM + 256 + tid] = 0; } continue; }
                    wy_prep<3>(a, pbuf, vfirst, LO, lds, l, c, row0, hrb, ts, tid);
                    if (wv_ < 4) { int r0_ = __builtin_amdgcn_readfirstlane(row0 + ts); asm volatile("" : "+s"(r0_)); wy_block<3>(acc, lds, h, lane, (bf16*)(lds + WY_UV) + (size_t)h * 64 * WY_TS, lds + WY_SCR + h * WY_WSCR, (float*)(lds + WY_SCR + h * WY_WSCR + 3584), mix + (size_t)r0_ * DM + 256 + h * 64, a.in[17] + l * 256 + h * 64, a.in[18] + l * 256 + h * 64); }
                    __syncthreads();
                }
            }
#endif
        }
        GBAR();

        { pg8::Gemm g{mix, (const bf16*)(wl + LW_OUT), MMAIN, DM, DM}; pg8::StaticOrder S; S.init(MMAIN, DM, G, bid);
          pg8::EpiResid E{hb, DM, ALPHA};
          pg8::gemm_phase<pg8::EpiResid, pg8::StaticOrder, true, true>((PG8_LAS unsigned char*)lds, g, S, E); }
        side_gemm<1>(mix + (size_t)MMAIN * DM, (const bf16*)(wl + LW_OUT), DM, DM, hb + (size_t)MMAIN * DM, DM, ALPHA, lds, bid, G);
        GBAR();
        { int tid = threadIdx.x; asm volatile("" : "+v"(tid)); unsigned char* ws = ws_g; asm volatile("" : "+s"(ws)); unsigned char* dsc = dsc_g; asm volatile("" : "+s"(dsc)); (void)ws; (void)dsc; const int lane = tid & 63, wave = __builtin_amdgcn_readfirstlane(tid >> 6); const int gw = bid * 8 + wave; (void)lane; (void)gw;
        for (int m = gw; m < MP; m += NGW) ln_row_bf16(hb + (size_t)m * DM, a.in[32] + l * DM, a.in[33] + l * DM, nullptr, lane);
        }
        GBAR();
        { pg8::Gemm g{hb, (const bf16*)(wl + LW_1), MMAIN, FF, DM}; pg8::StaticOrder S; S.init(MMAIN, FF, G, bid);
          pg8::EpiStore<2> E{ffh, FF};
          pg8::gemm_phase<pg8::EpiStore<2>, pg8::StaticOrder, true, true>((PG8_LAS unsigned char*)lds, g, S, E); }
        side_gemm<2>(hb + (size_t)MMAIN * DM, (const bf16*)(wl + LW_1), DM, FF, ffh + (size_t)MMAIN * FF, FF, 0.f, lds, bid, G);
        GBAR();
        { pg8::Gemm g{ffh, (const bf16*)(wl + LW_2), MMAIN, DM, FF}; pg8::StaticOrder S; S.init(MMAIN, DM, G, bid);
          pg8::EpiResid E{hb, DM, ALPHA};
          pg8::gemm_phase<pg8::EpiResid, pg8::StaticOrder, true, true>((PG8_LAS unsigned char*)lds, g, S, E); }
        side_gemm<1>(ffh + (size_t)MMAIN * FF, (const bf16*)(wl + LW_2), FF, DM, hb + (size_t)MMAIN * DM, DM, ALPHA, lds, bid, G);
        GBAR();
        { int tid = threadIdx.x; asm volatile("" : "+v"(tid)); unsigned char* ws = ws_g; asm volatile("" : "+s"(ws)); unsigned char* dsc = dsc_g; asm volatile("" : "+s"(dsc)); (void)ws; (void)dsc; const int lane = tid & 63, wave = __builtin_amdgcn_readfirstlane(tid >> 6); const int gw = bid * 8 + wave; (void)lane; (void)gw;
        if (l < DEPTH - 1) { for (int m = gw; m < MP; m += NGW) ln_row_bf16(hb + (size_t)m * DM, a.in[34] + l * DM, a.in[35] + l * DM, nullptr, lane); }
        else { for (int m = gw; m < NB * SEQ; m += NGW) ln_row_bf16(hb + (size_t)m * DM, a.in[34] + l * DM, a.in[35] + l * DM, a.out + (size_t)m * DM, lane); }
        }
        if (l < DEPTH - 1) GBAR();
    }
}

#undef hb
#undef pbuf
#undef mix
#undef acg
#undef ffh
#undef lruA
#undef lruH
#undef lruS
#undef mlN
#undef mlM
#undef mlB
#undef mlP
#undef vfirst
#undef rwP
#undef rwS
#undef mlC
extern "C" void kernel_launch(void* const* d_in, const int* in_sizes, int n_in, void* d_out, int out_size, void* d_ws, size_t ws_size, hipStream_t stream) {
    static int grid = 0;
    if (grid == 0) {
        if (n_in != 38 || out_size != NB * SEQ * DM || ws_size < WS_END) { fprintf(stderr, "kernel_launch: unexpected sizes n_in %d out %d ws %zu (need %zu)\n", n_in, out_size, ws_size, (size_t)WS_END); grid = -1; return; }
        int dev = 0, cus = 0, per_cu = 0;
        hipGetDevice(&dev); hipDeviceGetAttribute(&cus, hipDeviceAttributeMultiprocessorCount, dev);
        if (hipFuncSetAttribute((const void*)hybrid_fwd, hipFuncAttributeMaxDynamicSharedMemorySize, LDS_BYTES) != hipSuccess) { fprintf(stderr, "kernel_launch: hipFuncSetAttribute failed\n"); grid = -1; return; }
        if (hipOccupancyMaxActiveBlocksPerMultiprocessor(&per_cu, (const void*)hybrid_fwd, NTHR, LDS_BYTES) != hipSuccess || per_cu < 1) { fprintf(stderr, "kernel_launch: occupancy query says %d\n", per_cu); per_cu = 1; }
        (void)hipGetLastError();
        grid = cus * 1;
    }
    if (grid < 0) return;
    if (hipMemsetAsync((char*)d_ws + WS_BAR, 0, BAR_BYTES, stream) != hipSuccess) { fprintf(stderr, "kernel_launch: memset of the barrier words failed\n"); return; }
    Args a{};
    for (int i = 0; i < 38; ++i) a.in[i] = (const float*)d_in[i];
    a.out = (float*)d_out; a.ws = (unsigned char*)d_ws;
    void* args[] = {&a};
    hipError_t e = hipLaunchCooperativeKernel((const void*)hybrid_fwd, dim3(grid), dim3(NTHR), args, LDS_BYTES, stream);
    if (e != hipSuccess) fprintf(stderr, "cooperative launch failed: %s (grid %d)\n", hipGetErrorString(e), grid);
}
```
